# Optimizing an MI355X kernel written in HIP

```python
import jax, jax.numpy as jnp
from jax import lax
import numpy as np


D_MODEL = 2048
BATCH = 4
SEQ = 4096
DEPTH = 1

N_Q_HEADS = 8
N_KV_HEADS = 2
Q_PER_KV = N_Q_HEADS // N_KV_HEADS
HEAD_DIM = 128
WINDOW = 128
WBLK = 128
GLA_HEADS = 4
GLA_DK = 128
GLA_DV = 256
GLA_LOWRANK = 16
GLA_TAU = 16.0
GLA_CHUNK = 64
ATT_Q = N_Q_HEADS * HEAD_DIM
ATT_KV = N_KV_HEADS * HEAD_DIM
GLA_QK = GLA_HEADS * GLA_DK
GLA_V = GLA_HEADS * GLA_DV
MIX_WIDTH = ATT_Q + GLA_V
IN_SIZES = (ATT_Q, ATT_KV, ATT_KV, GLA_QK, GLA_QK, GLA_V, GLA_V, GLA_LOWRANK, GLA_LOWRANK)
IN_COLS = ATT_Q + 2 * ATT_KV + 2 * GLA_QK + 2 * GLA_V + 2 * GLA_LOWRANK
MEM_LEN = 256
X_HEADS = 4
X_HEAD_DIM = D_MODEL // X_HEADS
N_GROUPS = 4
EXPERTS_PER_GROUP = 8
N_EXPERTS = N_GROUPS * EXPERTS_PER_GROUP
TOP_K = 2
D_FF_EXPERT = D_MODEL // 2
MOE_BLOCK = 256
RMS_EPS = 1e-6
NEG_INF = -1e30

kernel_name = 'hymba_swa_alibi_bigla_hmoe_encoder'


def rmsnorm(x, gain):
    xf = x.astype(jnp.float32)
    y = xf * lax.rsqrt(jnp.mean(xf * xf, axis=-1, keepdims=True) + RMS_EPS)
    return (y * gain.astype(jnp.float32)).astype(x.dtype)


def alibi_slopes():
    return 2.0 ** (-8.0 * (jnp.arange(N_Q_HEADS, dtype=jnp.float32) + 1.0) / N_Q_HEADS)


def window_attention(q, k, v, sink_logit):
    B, S = q.shape[:2]
    nb = S // WBLK
    qb = q.reshape(B, nb, WBLK, N_KV_HEADS, Q_PER_KV, HEAD_DIM)
    pad = ((0, 0), (WBLK, WBLK), (0, 0), (0, 0))

    def band(t):
        tp = jnp.pad(t, pad).reshape(B, nb + 2, WBLK, N_KV_HEADS, HEAD_DIM)
        return jnp.concatenate([tp[:, :-2], tp[:, 1:-1], tp[:, 2:]], axis=2)

    kb, vb = band(k), band(v)
    scores = jnp.einsum('bnqhgd,bnkhd->bhgnqk', qb, kb).astype(jnp.float32) * (HEAD_DIM ** -0.5)
    kpos = jnp.arange(3 * WBLK)
    qpos = jnp.arange(WBLK) + WBLK
    dist = jnp.abs(kpos[None, :] - qpos[:, None])
    kabs = jnp.arange(nb)[:, None] * WBLK + kpos[None, :] - WBLK
    valid = (dist <= WINDOW)[None] & ((kabs >= 0) & (kabs < S))[:, None, :]
    slopes = alibi_slopes().reshape(N_KV_HEADS, Q_PER_KV)
    scores = scores - slopes[:, :, None, None, None] * dist.astype(jnp.float32)
    scores = jnp.where(valid, scores, NEG_INF)
    sink = sink_logit.astype(jnp.float32).reshape(N_KV_HEADS, Q_PER_KV)[None, :, :, None, None, None]
    sink = jnp.broadcast_to(sink, scores.shape[:-1] + (1,))
    probs = jax.nn.softmax(jnp.concatenate([scores, sink], axis=-1), axis=-1)[..., :-1]
    out = jnp.einsum('bhgnqk,bnkhd->bnqhgd', probs.astype(v.dtype), vb)
    return out.reshape(B, S, ATT_Q)


def gla_chunked(q, k, v, g):
    B, H, S, DK = q.shape
    DV = v.shape[-1]
    C = GLA_CHUNK
    N = S // C
    q = q.reshape(B, H, N, C, DK)
    k = k.reshape(B, H, N, C, DK)
    g = g.reshape(B, H, N, C, DK)
    v = v.reshape(B, H, N, C, DV)
    b = jnp.cumsum(g, axis=3)
    b_end = b[:, :, :, -1:, :]
    q_dec = q * jnp.exp(b)
    attn = jnp.einsum('bhncd,bhnsd->bhncs', q_dec, k * jnp.exp(-b))
    lower_tri = jnp.tril(jnp.ones((C, C), dtype=bool))
    attn = jnp.where(lower_tri, attn, 0.0)
    o = jnp.einsum('bhncs,bhnsv->bhncv', attn, v)
    chunk_kv = jnp.einsum('bhncd,bhncv->bhndv', k * jnp.exp(b_end - b), v)
    chunk_decay = jnp.exp(b_end[:, :, :, 0, :])

    def step(state, inp):
        dec, kv = inp
        return dec[..., None] * state + kv, state

    init = jnp.zeros((B, H, DK, DV), q.dtype)
    _, states = lax.scan(step, init, (jnp.moveaxis(chunk_decay, 2, 0), jnp.moveaxis(chunk_kv, 2, 0)))
    states = jnp.moveaxis(states, 0, 2)
    o = o + jnp.einsum('bhncd,bhndv->bhncv', q_dec, states)
    return o.reshape(B, H, S, DV)


def parallel_head_mixer(u, w_in, attn_out_norm, sink_logit, w_gla_gf, b_gla_gf, w_gla_gb, b_gla_gb, gla_out_norm, w_out):
    B, S, _ = u.shape
    proj = u @ w_in
    cuts = [sum(IN_SIZES[:i + 1]) for i in range(len(IN_SIZES) - 1)]
    q_a, k_a, v_a, q_g, k_g, v_g, r_g, lr_f, lr_b = jnp.split(proj, cuts, axis=-1)
    o_a = window_attention(q_a.reshape(B, S, N_KV_HEADS, Q_PER_KV, HEAD_DIM),
                           k_a.reshape(B, S, N_KV_HEADS, HEAD_DIM),
                           v_a.reshape(B, S, N_KV_HEADS, HEAD_DIM), sink_logit)
    o_a = rmsnorm(o_a, attn_out_norm)

    def heads(t, d):
        return t.reshape(B, S, GLA_HEADS, d).transpose(0, 2, 1, 3).astype(jnp.float32)

    qg = heads(q_g, GLA_DK) * (GLA_DK ** -0.5)
    kg = heads(k_g, GLA_DK)
    vg = heads(v_g, GLA_DV)
    g_f = heads(jax.nn.log_sigmoid((lr_f @ w_gla_gf + b_gla_gf).astype(jnp.float32)) / GLA_TAU, GLA_DK)
    g_b = heads(jax.nn.log_sigmoid((lr_b @ w_gla_gb + b_gla_gb).astype(jnp.float32)) / GLA_TAU, GLA_DK)
    o_fwd = gla_chunked(qg, kg, vg, g_f)
    flip = lambda t: jnp.flip(t, axis=2)
    o_bwd = flip(gla_chunked(flip(qg), flip(kg), flip(vg), flip(g_b)))
    o_g = rmsnorm(o_fwd + o_bwd, gla_out_norm)
    o_g = o_g.transpose(0, 2, 1, 3).reshape(B, S, GLA_V).astype(u.dtype) * jax.nn.silu(r_g)
    return jnp.concatenate([o_a.astype(u.dtype), o_g], axis=-1) @ w_out


def memory_cross_attention(hn, memn, w_cq, w_ck, w_cv, w_co):
    B, S, _ = hn.shape
    M = memn.shape[1]
    q = (hn @ w_cq).reshape(B, S, X_HEADS, X_HEAD_DIM)
    k = (memn @ w_ck).reshape(B, M, X_HEADS, X_HEAD_DIM)
    v = (memn @ w_cv).reshape(B, M, X_HEADS, X_HEAD_DIM)
    s = jnp.einsum('bshd,bmhd->bhsm', q, k).astype(jnp.float32) * (X_HEAD_DIM ** -0.5)
    p = jax.nn.softmax(s, axis=-1).astype(v.dtype)
    o = jnp.einsum('bhsm,bmhd->bshd', p, v).reshape(B, S, D_MODEL)
    return o @ w_co


def hierarchical_moe(hn, w_rg, b_rg, w_re, b_re, w_gate, w_up, w_down):
    B, S, D = hn.shape
    T = B * S
    xf = hn.reshape(T, D)
    g_logits = (xf @ w_rg).astype(jnp.float32) + b_rg.astype(jnp.float32)
    g_prob = jax.nn.softmax(g_logits, axis=-1)
    _, g_idx = lax.top_k(g_logits, 1)
    p_group = jnp.take_along_axis(g_prob, g_idx, axis=-1)
    e_logits = ((xf @ w_re).astype(jnp.float32) + b_re.astype(jnp.float32)).reshape(T, N_GROUPS, EXPERTS_PER_GROUP)
    sel = jnp.broadcast_to(g_idx[:, :, None], (T, 1, EXPERTS_PER_GROUP))
    in_group = jnp.take_along_axis(e_logits, sel, axis=1)[:, 0]
    e_top, e_local = lax.top_k(in_group, TOP_K)
    gate = jax.nn.softmax(e_top, axis=-1) * p_group
    e_idx = g_idx * EXPERTS_PER_GROUP + e_local

    A = T * TOP_K
    e_flat = e_idx.reshape(A)
    tok_flat = jnp.arange(A, dtype=jnp.int32) // TOP_K
    w_flat = gate.reshape(A)
    order = jnp.argsort(e_flat)
    e_s, tok_s, w_s = e_flat[order], tok_flat[order], w_flat[order]
    counts = jnp.zeros((N_EXPERTS,), jnp.int32).at[e_flat].add(1)
    padded = ((counts + MOE_BLOCK - 1) // MOE_BLOCK) * MOE_BLOCK
    start = jnp.cumsum(counts) - counts
    pend = jnp.cumsum(padded)
    pstart = pend - padded
    dest = pstart[e_s] + (jnp.arange(A, dtype=jnp.int32) - start[e_s])
    R = A + N_EXPERTS * MOE_BLOCK
    row_tok = jnp.zeros((R,), jnp.int32).at[dest].set(tok_s)
    row_w = jnp.zeros((R,), jnp.float32).at[dest].set(w_s)
    n_blk = R // MOE_BLOCK
    blk_e = jnp.minimum(jnp.searchsorted(pend, jnp.arange(n_blk, dtype=jnp.int32) * MOE_BLOCK, side='right'), N_EXPERTS - 1)
    xs = xf[row_tok].reshape(n_blk, MOE_BLOCK, D)

    def expert_block(args):
        xb, e = args
        hid = jax.nn.silu(xb @ w_gate[e]) * (xb @ w_up[e])
        return hid @ w_down[e]

    ys = lax.map(expert_block, (xs, blk_e)).reshape(R, D)
    out = jnp.zeros_like(xf).at[row_tok].add(ys * row_w[:, None].astype(ys.dtype))
    return out.reshape(B, S, D)


def setup_inputs(seed: int = 0) -> dict:
    key = jax.random.key(seed)
    ks = list(jax.random.split(key, 32))
    L = DEPTH
    cnt = [0]

    def nk():
        cnt[0] += 1
        return ks[cnt[0] - 1]

    def nrm(shape, fan_in):
        return jax.random.normal(nk(), shape, jnp.float32) * (fan_in ** -0.5)

    def gain(shape):
        return 1.0 + 0.05 * jax.random.normal(nk(), shape, jnp.float32)

    def small(shape, scale):
        return scale * jax.random.normal(nk(), shape, jnp.float32)

    return {
        'x': jax.random.normal(nk(), (BATCH, SEQ, D_MODEL), jnp.float32),
        'mem': jax.random.normal(nk(), (BATCH, MEM_LEN, D_MODEL), jnp.float32),
        'norm_mix': gain((L, D_MODEL)),
        'w_in': nrm((L, D_MODEL, IN_COLS), D_MODEL),
        'attn_out_norm': gain((L, ATT_Q)),
        'sink_logit': small((L, N_Q_HEADS), 0.5),
        'w_gla_gf': nrm((L, GLA_LOWRANK, GLA_QK), GLA_LOWRANK),
        'b_gla_gf': small((L, GLA_QK), 0.1),
        'w_gla_gb': nrm((L, GLA_LOWRANK, GLA_QK), GLA_LOWRANK),
        'b_gla_gb': small((L, GLA_QK), 0.1),
        'gla_out_norm': gain((L, GLA_DV)),
        'w_out': nrm((L, MIX_WIDTH, D_MODEL), MIX_WIDTH),
        'norm_cross': gain((L, D_MODEL)),
        'norm_mem': gain((L, D_MODEL)),
        'w_cq': nrm((L, D_MODEL, D_MODEL), D_MODEL),
        'w_ck': nrm((L, D_MODEL, D_MODEL), D_MODEL),
        'w_cv': nrm((L, D_MODEL, D_MODEL), D_MODEL),
        'w_co': nrm((L, D_MODEL, D_MODEL), D_MODEL),
        'norm_ffn': gain((L, D_MODEL)),
        'w_router_group': nrm((L, D_MODEL, N_GROUPS), D_MODEL),
        'b_router_group': small((L, N_GROUPS), 0.01),
        'w_router_expert': nrm((L, D_MODEL, N_EXPERTS), D_MODEL),
        'b_router_expert': small((L, N_EXPERTS), 0.01),
        'w_gate': nrm((L, N_EXPERTS, D_MODEL, D_FF_EXPERT), D_MODEL),
        'w_up': nrm((L, N_EXPERTS, D_MODEL, D_FF_EXPERT), D_MODEL),
        'w_down': nrm((L, N_EXPERTS, D_FF_EXPERT, D_MODEL), D_FF_EXPERT),
        'norm_final': gain((D_MODEL,)),
    }


def reference(x, mem, norm_mix, w_in, attn_out_norm, sink_logit, w_gla_gf, b_gla_gf, w_gla_gb, b_gla_gb,
              gla_out_norm, w_out, norm_cross, norm_mem, w_cq, w_ck, w_cv, w_co, norm_ffn,
              w_router_group, b_router_group, w_router_expert, b_router_expert, w_gate, w_up, w_down,
              norm_final):
    h = x
    for l in range(DEPTH):
        h = h + parallel_head_mixer(rmsnorm(h, norm_mix[l]), w_in[l], attn_out_norm[l], sink_logit[l],
                                    w_gla_gf[l], b_gla_gf[l], w_gla_gb[l], b_gla_gb[l], gla_out_norm[l], w_out[l])
        h = h + memory_cross_attention(rmsnorm(h, norm_cross[l]), rmsnorm(mem, norm_mem[l]),
                                       w_cq[l], w_ck[l], w_cv[l], w_co[l])
        h = h + hierarchical_moe(rmsnorm(h, norm_ffn[l]), w_router_group[l], b_router_group[l],
                                 w_router_expert[l], b_router_expert[l], w_gate[l], w_up[l], w_down[l])
    return rmsnorm(h, norm_final)
```

```cpp
#define DBG_THR 0.06f
#ifndef SCAN_REP
#define SCAN_REP 1
#define ATT_REP 1
#define MOE1_REP 1
#define MOE2_REP 1
#endif
#ifndef P7_DRY
#define P7_DRY 0
#define P12_DRY 0
#define P0E_REP 0
#define XBAR_EXTRA 0
#define P0E_NOSTORE 0
#define X3_DRY 0
#define PRE_REP 1
#define P0T_REP 1
#define P0R_REP 1
#endif
#ifndef RPT
#define RPT -1
#endif
#include <hip/hip_runtime.h>
#include <hip/hip_cooperative_groups.h>
#include <cstdio>
#include <cstdint>
namespace cg = cooperative_groups;

#define LAS __attribute__((address_space(3)))
typedef unsigned short bf16_t;
typedef short bf16x8 __attribute__((ext_vector_type(8)));
typedef short s16x4 __attribute__((ext_vector_type(4)));
typedef float f32x2 __attribute__((ext_vector_type(2)));
typedef float f32x4 __attribute__((ext_vector_type(4)));
typedef float f32x16 __attribute__((ext_vector_type(16)));
typedef unsigned u32x2 __attribute__((ext_vector_type(2)));
typedef unsigned u32x4 __attribute__((ext_vector_type(4)));
typedef __bf16 bf16v2 __attribute__((ext_vector_type(2)));
typedef int i32x8 __attribute__((ext_vector_type(8)));
typedef int i32x4 __attribute__((ext_vector_type(4)));

constexpr int DM = 2048, NB = 4, SEQ = 4096, NT = NB * SEQ;
constexpr int PLD = 4864;
constexpr int C_QA = 0, C_KA = 1024, C_VA = 1280, C_QG = 1536, C_KG = 2048, C_VG = 2560, C_RG = 3584, C_LRF = 4608, C_LRB = 4624;
constexpr int NEXP = 32, DFF = 1024, MEML = 256;
constexpr int RMAX = NT * 2 + NEXP * 256;
constexpr float EPS = 1e-6f;
constexpr float WQK_SCALE = 64.f, WVO_SCALE = 8.f, P_SCALE = 256.f;
constexpr float W_SCALE = 64.f, HID_SCALE = 8.f, YS_SCALE = 16.f;

constexpr size_t MiB = 1u << 20;
constexpr size_t WS_CTL = 0;
constexpr size_t WS_WR = 1 * MiB;
constexpr size_t WS_ASG = 1 * MiB + 512 * 1024;
constexpr size_t WS_GD = 2 * MiB + 512 * 1024;
constexpr size_t WS_WGU = 4 * MiB;
constexpr size_t WS_WD = 260 * MiB;
constexpr size_t WS_WIN = 388 * MiB;
constexpr size_t WS_WCKV = 407 * MiB;
constexpr size_t WS_WOUT = 423 * MiB;
constexpr size_t WS_WCO = 431 * MiB;
constexpr size_t WS_WCQ = 439 * MiB;
constexpr size_t WS_WQK = 447 * MiB;
constexpr size_t WS_WVO = 463 * MiB;
constexpr size_t WS_U = 479 * MiB;
constexpr size_t WS_H1B = 479 * MiB;
constexpr size_t WS_MEMN = 543 * MiB;
constexpr size_t WS_MEMK = 547 * MiB;
constexpr size_t WS_MEMV = 551 * MiB;
constexpr size_t WS_PROJ = 555 * MiB;
constexpr size_t WS_P = 555 * MiB;
constexpr size_t WS_GQ = 707 * MiB;
constexpr size_t WS_GK = 739 * MiB;
constexpr size_t WS_O1 = 771 * MiB;
constexpr size_t WS_O2 = 803 * MiB;
constexpr size_t WS_O3 = 835 * MiB;
constexpr size_t WS_A2 = 867 * MiB;
constexpr size_t WS_H1F8 = 771 * MiB;
constexpr size_t WS_SSQ = 931 * MiB;
constexpr size_t WS_XS = 555 * MiB;
constexpr size_t WS_HID = 715 * MiB;
constexpr size_t WS_YS = 795 * MiB;
constexpr size_t WS_FIMG = 955 * MiB;
constexpr size_t WS_SEGD = 987 * MiB;
constexpr size_t WS_END = 988 * MiB;
constexpr int CW_CNT = 0;
constexpr int CW_BAR = 4096;

constexpr int LDS_BYTES = 155648;
constexpr int MISC_OFF = 147456;

__device__ __forceinline__ unsigned pk2(float lo, float hi) { f32x2 v = {lo, hi}; bf16v2 b = __builtin_convertvector(v, bf16v2); return __builtin_bit_cast(unsigned, b); }
__device__ __forceinline__ float clamp8(float v) { return fminf(fmaxf(v, -448.f), 448.f); }
__device__ __forceinline__ unsigned pk4_fp8(float a, float b, float c, float d) { int w = 0; w = __builtin_amdgcn_cvt_pk_fp8_f32(clamp8(a), clamp8(b), w, false); w = __builtin_amdgcn_cvt_pk_fp8_f32(clamp8(c), clamp8(d), w, true); return (unsigned)w; }
__device__ __forceinline__ float fp8f(unsigned char x) { return __builtin_amdgcn_cvt_f32_fp8((int)x, 0); }
__device__ __forceinline__ float bf2f(unsigned short x) { return __uint_as_float(((unsigned)x) << 16); }
__device__ __forceinline__ float bflo(unsigned w) { return __uint_as_float(w << 16); }
__device__ __forceinline__ float bfhi(unsigned w) { return __uint_as_float(w & 0xffff0000u); }
__device__ __forceinline__ float wave_sum(float v) {
#pragma unroll
    for (int o = 1; o < 64; o <<= 1) v += __shfl_xor(v, o);
    return v;
}
__device__ __forceinline__ bf16x8 pack8(const float* v) { u32x4 p; p.x = pk2(v[0], v[1]); p.y = pk2(v[2], v[3]); p.z = pk2(v[4], v[5]); p.w = pk2(v[6], v[7]); return __builtin_bit_cast(bf16x8, p); }
__device__ __forceinline__ void unpack8(bf16x8 b, float* v) { u32x4 p = __builtin_bit_cast(u32x4, b); v[0] = bflo(p.x); v[1] = bfhi(p.x); v[2] = bflo(p.y); v[3] = bfhi(p.y); v[4] = bflo(p.z); v[5] = bfhi(p.z); v[6] = bflo(p.w); v[7] = bfhi(p.w); }
__device__ __forceinline__ int lane_id_v() { int l; asm volatile("v_mbcnt_lo_u32_b32 %0, -1, 0\n\tv_mbcnt_hi_u32_b32 %0, -1, %0" : "=v"(l)); return l & 63; }
__device__ __forceinline__ int crow(int r, int hi) { return (r & 3) + 8 * (r >> 2) + 4 * hi; }
__device__ __forceinline__ bf16x8 pack_step(const f32x16& x, int s) {
    u32x4 p; p.x = pk2(x[8 * s], x[8 * s + 1]); p.y = pk2(x[8 * s + 2], x[8 * s + 3]); p.z = pk2(x[8 * s + 4], x[8 * s + 5]); p.w = pk2(x[8 * s + 6], x[8 * s + 7]);
    return __builtin_bit_cast(bf16x8, p);
}
__device__ __forceinline__ bf16x8 tr_read2(unsigned a0, unsigned a1) {
    s16x4 lo, hi;
    asm volatile("ds_read_b64_tr_b16 %0, %2\n\tds_read_b64_tr_b16 %1, %3\n\ts_waitcnt lgkmcnt(0)" : "=&v"(lo), "=&v"(hi) : "v"(a0), "v"(a1) : "memory");
    return __builtin_shufflevector(lo, hi, 0, 1, 2, 3, 4, 5, 6, 7);
}

template <int OA, int OB>
__device__ __forceinline__ void tr8(unsigned a, bf16x8 (&f)[4]) {
    s16x4 r0, r1, r2, r3, r4, r5, r6, r7;
    asm volatile("ds_read_b64_tr_b16 %0, %8\n\tds_read_b64_tr_b16 %1, %8 offset:%9\n\tds_read_b64_tr_b16 %2, %8 offset:%10\n\tds_read_b64_tr_b16 %3, %8 offset:%11\n\t"
                 "ds_read_b64_tr_b16 %4, %8 offset:%12\n\tds_read_b64_tr_b16 %5, %8 offset:%13\n\tds_read_b64_tr_b16 %6, %8 offset:%14\n\tds_read_b64_tr_b16 %7, %8 offset:%15\n\ts_waitcnt lgkmcnt(0)"
                 : "=&v"(r0), "=&v"(r1), "=&v"(r2), "=&v"(r3), "=&v"(r4), "=&v"(r5), "=&v"(r6), "=&v"(r7)
                 : "v"(a), "i"(OB), "i"(OA), "i"(OA + OB), "i"(2 * OA), "i"(2 * OA + OB), "i"(3 * OA), "i"(3 * OA + OB) : "memory");
    f[0] = __builtin_shufflevector(r0, r1, 0, 1, 2, 3, 4, 5, 6, 7); f[1] = __builtin_shufflevector(r2, r3, 0, 1, 2, 3, 4, 5, 6, 7);
    f[2] = __builtin_shufflevector(r4, r5, 0, 1, 2, 3, 4, 5, 6, 7); f[3] = __builtin_shufflevector(r6, r7, 0, 1, 2, 3, 4, 5, 6, 7);
}
__device__ __forceinline__ void tr_scan10(unsigned va, unsigned ka, bf16x8& bv, bf16x8 (&ak)[4]) {
    s16x4 v0, v1, r0, r1, r2, r3, r4, r5, r6, r7;
    asm volatile("ds_read_b64_tr_b16 %0, %10\n\tds_read_b64_tr_b16 %1, %10 offset:2112\n\t"
                 "ds_read_b64_tr_b16 %2, %11\n\tds_read_b64_tr_b16 %3, %11 offset:1088\n\tds_read_b64_tr_b16 %4, %11 offset:64\n\tds_read_b64_tr_b16 %5, %11 offset:1152\n\t"
                 "ds_read_b64_tr_b16 %6, %11 offset:128\n\tds_read_b64_tr_b16 %7, %11 offset:1216\n\tds_read_b64_tr_b16 %8, %11 offset:192\n\tds_read_b64_tr_b16 %9, %11 offset:1280\n\ts_waitcnt lgkmcnt(0)"
                 : "=&v"(v0), "=&v"(v1), "=&v"(r0), "=&v"(r1), "=&v"(r2), "=&v"(r3), "=&v"(r4), "=&v"(r5), "=&v"(r6), "=&v"(r7) : "v"(va), "v"(ka) : "memory");
    bv = __builtin_shufflevector(v0, v1, 0, 1, 2, 3, 4, 5, 6, 7);
    ak[0] = __builtin_shufflevector(r0, r1, 0, 1, 2, 3, 4, 5, 6, 7); ak[1] = __builtin_shufflevector(r2, r3, 0, 1, 2, 3, 4, 5, 6, 7);
    ak[2] = __builtin_shufflevector(r4, r5, 0, 1, 2, 3, 4, 5, 6, 7); ak[3] = __builtin_shufflevector(r6, r7, 0, 1, 2, 3, 4, 5, 6, 7);
}
__device__ __forceinline__ void lds_barrier() { asm volatile("s_waitcnt lgkmcnt(0)" ::: "memory"); __builtin_amdgcn_s_barrier(); asm volatile("" ::: "memory"); }
#define MFMA32(a, b, c) __builtin_amdgcn_mfma_f32_32x32x16_bf16((a), (b), (c), 0, 0, 0)

namespace pg8 {
constexpr int BM = 256, BK = 64, HALF = 128, HTB = HALF * BK * 2, STAGE_BYTES = 8 * HTB, NXCD = 8, WGM = 8;
__host__ __device__ __forceinline__ int lds_byte(int r, int c) { const int st = (r >> 4) * 2 + (c >> 5), rr = r & 15, cc = c & 31, ob = rr * 64 + cc * 2; return st * 1024 + (ob ^ (((ob >> 9) & 1) << 5)); }
__host__ __device__ __forceinline__ void stage_rc(int b, int& R, int& C) { const int st = b / 1024, sb = b % 1024, swz = sb ^ (((sb >> 9) & 1) << 5); R = (st >> 1) * 16 + swz / 64; C = (st & 1) * 32 + (swz % 64) / 2; }
__host__ __device__ __forceinline__ int perm32(int rho) { const int n = rho >> 4, i = rho & 15; return 8 * (i >> 2) + 4 * n + (i & 3); }

struct Unit { const char* a; const char* b; char* o; int pm, pn, ldo, z; };

__device__ __forceinline__ void tile_map(int L, int nM, int nN, int& pm, int& pn) {
    const int nwg = nM * nN; int wgid = L;
    { const int q = nwg / NXCD, r = nwg % NXCD, xcd = wgid % NXCD, off = wgid / NXCD; wgid = (xcd < r ? xcd * (q + 1) : r * (q + 1) + (xcd - r) * q) + off; }
    const int nig = WGM * nN, gid = wgid / nig, fm = gid * WGM, gsz = (nM - fm) < WGM ? (nM - fm) : WGM;
    pm = fm + ((wgid % nig) % gsz); pn = (wgid % nig) / gsz;
}

template <class Epi, class Sched, bool ALIGN_EPI, bool FP8 = false, bool GATHER = false>
__device__ __forceinline__ void gemm_phase(LAS unsigned char* lds, const int ldb  , const int nt_arg  , const Sched& S, const Epi& E, const int wid) {
    int nt = nt_arg; asm volatile("" : "+s"(nt));
    const int lane = lane_id_v(), tid = wid * 64 + lane, wr = wid >> 2, wc = wid & 3, fr = lane & 15, fq = lane >> 4;
    unsigned voffA[2], voffB[2];
#pragma unroll
    for (int i = 0; i < 2; ++i) { int R, C; stage_rc(tid * 16 + i * 8192, R, C); const int Rb = (R & ~31) + perm32(R & 31);
        voffA[i] = (unsigned)(R * ldb + C * 2); voffB[i] = (unsigned)(Rb * ldb + C * 2); }
    const size_t kstep = (size_t)(BK * 2);
    const size_t hstep = (size_t)HALF * ldb;
    const unsigned ldsw = (unsigned)wid * 1024u;
    const int aoff = lds_byte(wr * 64 + fr, fq * 8), boff = lds_byte(wc * 32 + fr, fq * 8);
#define PG8_SA(b, h) (((b) * 2 + (h)) * HTB)
#define PG8_SB(b, h) ((4 + (b) * 2 + (h)) * HTB)
#define PG8_STAGE(bufoff, gbase, voff) do { _Pragma("unroll") for (int _i = 0; _i < 2; ++_i) \
        __builtin_amdgcn_global_load_lds((const unsigned*)((const char*)(gbase) + (voff)[_i]), (LAS unsigned*)(lds + (bufoff) + ldsw + _i * 8192), 16, 0, 0); } while (0)
#define PG8_GOFF(slot, half) (LAS u32x2*)(lds + 131072 + ((((slot) & 1) * 2 + (half)) * 512 + tid) * 8)
#define PG8_STAGE_A(bufoff, gbase, half, usenext) do { if constexpr (GATHER) { const u32x2 _go = *PG8_GOFF(ui + ((usenext) ? 1 : 0), half); _Pragma("unroll") for (int _i = 0; _i < 2; ++_i) \
        __builtin_amdgcn_global_load_lds((const unsigned*)((const char*)(gbase) + _go[_i]), (LAS unsigned*)(lds + (bufoff) + ldsw + _i * 8192), 16, 0, 0); } \
        else { PG8_STAGE(bufoff, (const char*)(gbase) + (half) * hstep, voffA); } } while (0)
#define PG8_LDA(dst, b, h) do { _Pragma("unroll") for (int m = 0; m < 4; ++m) { if constexpr (FP8) dst##8[m] = __builtin_shufflevector(*(const LAS i32x4*)(lds + PG8_SA(b, h) + aoff + m * 2048), *(const LAS i32x4*)(lds + PG8_SA(b, h) + aoff + m * 2048 + 1024), 0, 1, 2, 3, 4, 5, 6, 7); \
        else { _Pragma("unroll") for (int k = 0; k < 2; ++k) dst[m][k] = *(const LAS bf16x8*)(lds + PG8_SA(b, h) + aoff + m * 2048 + k * 1024); } } } while (0)
#define PG8_LDB(dst, b, h) do { _Pragma("unroll") for (int n = 0; n < 2; ++n) { if constexpr (FP8) dst##8[n] = __builtin_shufflevector(*(const LAS i32x4*)(lds + PG8_SB(b, h) + boff + n * 2048), *(const LAS i32x4*)(lds + PG8_SB(b, h) + boff + n * 2048 + 1024), 0, 1, 2, 3, 4, 5, 6, 7); \
        else { _Pragma("unroll") for (int k = 0; k < 2; ++k) dst[n][k] = *(const LAS bf16x8*)(lds + PG8_SB(b, h) + boff + n * 2048 + k * 1024); } } } while (0)
#define PG8_MMA(ai, bj, At, Bt) do { __builtin_amdgcn_s_setprio(1); _Pragma("unroll") for (int m = 0; m < 4; ++m) _Pragma("unroll") for (int n = 0; n < 2; ++n) { \
        if constexpr (FP8) { asm volatile("v_mfma_scale_f32_16x16x128_f8f6f4 %0, %1, %2, %0, %3, %3 op_sel_hi:[0,0,0]" : "+v"(acc[ai][bj][m][n]) : "v"(Bt##8[n]), "v"(At##8[m]), "v"(sc1)); } \
        else { _Pragma("unroll") for (int k = 0; k < 2; ++k) acc[ai][bj][m][n] = __builtin_amdgcn_mfma_f32_16x16x32_bf16(Bt[n][k], At[m][k], acc[ai][bj][m][n], 0, 0, 0); } } \
        __builtin_amdgcn_s_setprio(0); } while (0)
#define PG8_WAIT_V(n) asm volatile("s_waitcnt vmcnt(" #n ")" ::: "memory")
#define PG8_WAIT_L(n) asm volatile("s_waitcnt lgkmcnt(" #n ")" ::: "memory")
#define PG8_BAR __builtin_amdgcn_s_barrier()
#define PG8_SCHED __builtin_amdgcn_sched_barrier(0)
    Unit cur, nxt; int ui = 0;
    if (!S.next(0, cur)) return;
    f32x4 acc[2][2][4][2];
#pragma unroll
    for (int a = 0; a < 2; ++a)
#pragma unroll
        for (int b = 0; b < 2; ++b)
#pragma unroll
            for (int m = 0; m < 4; ++m)
#pragma unroll
                for (int n = 0; n < 2; ++n) acc[a][b][m][n] = (f32x4){0.f, 0.f, 0.f, 0.f};
    int sc1 = 0x7f7f7f7f; asm volatile("" : "+v"(sc1));
    bf16x8 At[4][2], B0[2][2], B1[2][2]; i32x8 At8[4], B08[2], B18[2]; (void)At; (void)B0; (void)B1; (void)At8; (void)B08; (void)B18;
    const char* cA = cur.a; const char* cB = cur.b;
    if constexpr (GATHER) { S.rs_fill(cur, tid);
#pragma unroll
        for (int hf = 0; hf < 2; ++hf) { u32x2 go;
#pragma unroll
            for (int i = 0; i < 2; ++i) { int R, C; stage_rc(tid * 16 + i * 8192, R, C); go[i] = (unsigned)S.rowtok(cur, hf * HALF + R) * (unsigned)ldb + (unsigned)(C * 2); }
            *PG8_GOFF(0, hf) = go; } }
    PG8_STAGE(PG8_SB(0, 0), cB, voffB); PG8_STAGE(PG8_SB(0, 1), cB + hstep, voffB); PG8_STAGE_A(PG8_SA(0, 0), cA, 0, false); PG8_STAGE_A(PG8_SA(0, 1), cA, 1, false);
    if (wr == 1) PG8_BAR;
    PG8_WAIT_V(2); PG8_BAR;
    PG8_STAGE(PG8_SB(1, 0), cB + kstep, voffB); PG8_STAGE_A(PG8_SA(1, 0), cA + kstep, 0, false); PG8_STAGE(PG8_SB(1, 1), cB + hstep + kstep, voffB);
    PG8_WAIT_V(6); PG8_BAR;
    for (;;) {
        const bool has_next = S.next(ui + 1, nxt);
        const char* nA = has_next ? nxt.a : cA; const char* nB = has_next ? nxt.b : cB;
        if constexpr (GATHER) { if (has_next) S.rs_fill(nxt, tid);
#pragma unroll
            for (int hf = 0; hf < 2; ++hf) { u32x2 go;
                if (has_next) {
#pragma unroll
                    for (int i = 0; i < 2; ++i) { int R, C; stage_rc(tid * 16 + i * 8192, R, C); go[i] = (unsigned)S.rowtok(nxt, hf * HALF + R) * (unsigned)ldb + (unsigned)(C * 2); } }
                else go = *PG8_GOFF(ui, hf);
                *PG8_GOFF(ui + 1, hf) = go; } }
#pragma unroll 1
        for (int t = 0; t < nt; t += 2) {
            const bool last = (t == nt - 2);
            const char* a1 = cA + (size_t)(t + 1) * kstep;
            const char* a2 = last ? nA : cA + (size_t)(t + 2) * kstep; const char* b2 = last ? nB : cB + (size_t)(t + 2) * kstep;
            const char* a3 = a2 + kstep; const char* b3 = b2 + kstep;
            PG8_LDB(B0, 0, 0); PG8_LDB(B1, 0, 1); PG8_SCHED; PG8_LDA(At, 0, 0); PG8_STAGE_A(PG8_SA(1, 1), a1, 1, false);
            PG8_WAIT_V(8); PG8_WAIT_L(0); PG8_BAR; PG8_MMA(0, 0, At, B0); PG8_MMA(0, 1, At, B1); PG8_BAR; PG8_SCHED;
            PG8_LDA(At, 0, 1); PG8_STAGE(PG8_SB(0, 0), b2, voffB); PG8_STAGE(PG8_SB(0, 1), b2 + hstep, voffB); PG8_STAGE_A(PG8_SA(0, 0), a2, 0, last);
            PG8_WAIT_V(8); PG8_WAIT_L(0); PG8_BAR; PG8_MMA(1, 0, At, B0); PG8_MMA(1, 1, At, B1); PG8_BAR; PG8_SCHED;
            PG8_LDB(B0, 1, 0); PG8_LDB(B1, 1, 1); PG8_SCHED; PG8_LDA(At, 1, 0); PG8_STAGE_A(PG8_SA(0, 1), a2, 1, last);
            PG8_WAIT_V(8); PG8_WAIT_L(0); PG8_BAR; PG8_MMA(0, 0, At, B0); PG8_MMA(0, 1, At, B1); PG8_BAR; PG8_SCHED;
            PG8_LDA(At, 1, 1); PG8_STAGE(PG8_SB(1, 0), b3, voffB); PG8_STAGE(PG8_SB(1, 1), b3 + hstep, voffB); PG8_STAGE_A(PG8_SA(1, 0), a3, 0, last);
            PG8_WAIT_V(8); PG8_WAIT_L(0); PG8_BAR; PG8_MMA(1, 0, At, B0); PG8_MMA(1, 1, At, B1); PG8_BAR; PG8_SCHED;
        }
        if constexpr (ALIGN_EPI) { if (wr == 0) PG8_BAR; }
        if constexpr (FP8) asm volatile("s_nop 15\n\ts_nop 15" ::: "memory");
        if constexpr (!Epi::AFTER_DRAIN) { E(acc, cur, wr, wc, fr, fq); }
        if (!has_next) break;
#pragma unroll
        for (int a = 0; a < 2; ++a)
#pragma unroll
            for (int b = 0; b < 2; ++b)
#pragma unroll
                for (int m = 0; m < 4; ++m)
#pragma unroll
                    for (int n = 0; n < 2; ++n) acc[a][b][m][n] = (f32x4){0.f, 0.f, 0.f, 0.f};
        cur = nxt; cA = nA; cB = nB; ++ui;
        if constexpr (ALIGN_EPI) { if (wr == 1) PG8_BAR; }
    }
    PG8_WAIT_V(0);
    if constexpr (!ALIGN_EPI) { if (wr == 0) PG8_BAR; }
    PG8_BAR;
    if constexpr (Epi::AFTER_DRAIN) { if constexpr (FP8) asm volatile("s_nop 15\n\ts_nop 15" ::: "memory"); E.fused(acc, cur, wr, wc, fr, fq, lds, wid, lane); }
#undef PG8_SA
#undef PG8_SB
#undef PG8_STAGE
#undef PG8_STAGE_A
#undef PG8_GOFF
#undef PG8_LDA
#undef PG8_LDB
#undef PG8_MMA
#undef PG8_WAIT_V
#undef PG8_WAIT_L
#undef PG8_BAR
#undef PG8_SCHED
}

typedef f32x4 Acc[2][2][4][2];

struct EpiStore {
    static constexpr bool AFTER_DRAIN = false;
    const float* cs; float sc;
    __device__ __forceinline__ void operator()(const Acc& acc, const Unit& u, int wr, int wc, int fr, int fq) const {
        bf16_t* base = (bf16_t*)u.o; int r0 = wr * 64 + fr; asm volatile("" : "+v"(r0)); const int c0 = wc * 32 + 8 * fq;
        f32x4 s[2][2];
#pragma unroll
        for (int bj = 0; bj < 2; ++bj)
#pragma unroll
            for (int n = 0; n < 2; ++n) { s[bj][n] = (f32x4){1.f, 1.f, 1.f, 1.f}; if (u.z == 0) { s[bj][n] = (f32x4){sc, sc, sc, sc}; if (cs) s[bj][n] = s[bj][n] * *(const f32x4*)(cs + u.pn * 256 + bj * HALF + c0 + 4 * n); } }
#pragma unroll
        for (int ai = 0; ai < 2; ++ai)
#pragma unroll
            for (int m = 0; m < 4; ++m) { bf16_t* rowp = base + (size_t)(r0 + ai * HALF + m * 16) * u.ldo + c0;
#pragma unroll
                for (int bj = 0; bj < 2; ++bj) { const f32x4 v0 = acc[ai][bj][m][0] * s[bj][0], v1 = acc[ai][bj][m][1] * s[bj][1];
                    u32x4 w; w.x = pk2(v0[0], v0[1]); w.y = pk2(v0[2], v0[3]); w.z = pk2(v1[0], v1[1]); w.w = pk2(v1[2], v1[3]);
                    *(u32x4*)(rowp + bj * HALF) = w; } }
    }
};
struct EpiStore8 {
    static constexpr bool AFTER_DRAIN = false;
    const float* cs; float sc0, sc1;
    __device__ __forceinline__ void operator()(const Acc& acc, const Unit& u, int wr, int wc, int fr, int fq) const {
        unsigned char* base = (unsigned char*)u.o; int r0 = wr * 64 + fr; asm volatile("" : "+v"(r0)); const int c0 = wc * 32 + 8 * fq;
        f32x4 s[2][2];
#pragma unroll
        for (int bj = 0; bj < 2; ++bj)
#pragma unroll
            for (int n = 0; n < 2; ++n) { s[bj][n] = (f32x4){sc1, sc1, sc1, sc1}; if (u.z == 0) s[bj][n] = *(const f32x4*)(cs + u.pn * 256 + bj * HALF + c0 + 4 * n) * sc0; }
#pragma unroll
        for (int ai = 0; ai < 2; ++ai)
#pragma unroll
            for (int m = 0; m < 4; ++m) { unsigned char* rowp = base + (size_t)(r0 + ai * HALF + m * 16) * u.ldo + c0;
#pragma unroll
                for (int bj = 0; bj < 2; ++bj) { const f32x4 v0 = acc[ai][bj][m][0] * s[bj][0], v1 = acc[ai][bj][m][1] * s[bj][1];
                    u32x2 w; w.x = pk4_fp8(v0[0], v0[1], v0[2], v0[3]); w.y = pk4_fp8(v1[0], v1[1], v1[2], v1[3]); *(u32x2*)(rowp + bj * HALF) = w; } }
    }
};
struct EpiRes1 {
    static constexpr bool AFTER_DRAIN = false;
    const float* x; bf16_t* h1b; unsigned char* h1f8; float* ssq;
    __device__ __forceinline__ void operator()(const Acc& acc, const Unit& u, int wr, int wc, int fr, int fq) const {
        asm volatile("" : "+v"(fr)); const int c0 = u.pn * 256 + wc * 32 + 8 * fq;
#pragma unroll
        for (int ai = 0; ai < 2; ++ai) {
            f32x4 xv[4][2][2];
#pragma unroll
            for (int m = 0; m < 4; ++m) { const size_t off = (size_t)(u.pm * 256 + ai * HALF + wr * 64 + m * 16 + fr) * DM + c0;
#pragma unroll
                for (int bj = 0; bj < 2; ++bj) { xv[m][bj][0] = *(const f32x4*)(x + off + bj * HALF); xv[m][bj][1] = *(const f32x4*)(x + off + bj * HALF + 4); } }
#pragma unroll
            for (int m = 0; m < 4; ++m) { const int grow = u.pm * 256 + ai * HALF + wr * 64 + m * 16 + fr; const size_t off = (size_t)grow * DM + c0; float ss = 0.f;
#pragma unroll
                for (int bj = 0; bj < 2; ++bj) { const f32x4 v0 = acc[ai][bj][m][0] + xv[m][bj][0], v1 = acc[ai][bj][m][1] + xv[m][bj][1];
                    u32x4 w; w.x = pk2(v0[0], v0[1]); w.y = pk2(v0[2], v0[3]); w.z = pk2(v1[0], v1[1]); w.w = pk2(v1[2], v1[3]);
                    *(u32x4*)(h1b + off + bj * HALF) = w;
                    { u32x2 w8; w8.x = pk4_fp8(v0[0], v0[1], v0[2], v0[3]); w8.y = pk4_fp8(v1[0], v1[1], v1[2], v1[3]); *(u32x2*)(h1f8 + off + bj * HALF) = w8; }
                    ss += (v0[0] * v0[0] + v0[1] * v0[1]) + (v0[2] * v0[2] + v0[3] * v0[3]) + (v1[0] * v1[0] + v1[1] * v1[1]) + (v1[2] * v1[2] + v1[3] * v1[3]); }
                ss += __shfl_xor(ss, 16); ss += __shfl_xor(ss, 32);
                if (fq == 0) ssq[(size_t)grow * 32 + u.pn * 4 + wc] = ss; }
            asm volatile("" ::: "memory");
        }
    }
};
template <bool HN> struct EpiRes2 {
    static constexpr bool AFTER_DRAIN = false; static constexpr float sc = 1.f / (P_SCALE * WVO_SCALE);
    const bf16_t* h1b; bf16_t* ho; unsigned char* hn8; const float* gain;
    __device__ __forceinline__ void operator()(const Acc& acc, const Unit& u, int wr, int wc, int fr, int fq) const {
        asm volatile("" : "+v"(fr)); const int c0 = u.pn * 256 + wc * 32 + 8 * fq;
#pragma unroll
        for (int ai = 0; ai < 2; ++ai) {
            u32x4 xv[4][2];
#pragma unroll
            for (int m = 0; m < 4; ++m) { const size_t off = (size_t)(u.pm * 256 + ai * HALF + wr * 64 + m * 16 + fr) * DM + c0;
#pragma unroll
                for (int bj = 0; bj < 2; ++bj) xv[m][bj] = *(const u32x4*)(h1b + off + bj * HALF); }
#pragma unroll
            for (int m = 0; m < 4; ++m) { const size_t off = (size_t)(u.pm * 256 + ai * HALF + wr * 64 + m * 16 + fr) * DM + c0;
#pragma unroll
                for (int bj = 0; bj < 2; ++bj) { const u32x4 w = xv[m][bj]; const f32x4 v0 = acc[ai][bj][m][0] * sc + (f32x4){bflo(w.x), bfhi(w.x), bflo(w.y), bfhi(w.y)}, v1 = acc[ai][bj][m][1] * sc + (f32x4){bflo(w.z), bfhi(w.z), bflo(w.w), bfhi(w.w)};
                    u32x4 o; o.x = pk2(v0[0], v0[1]); o.y = pk2(v0[2], v0[3]); o.z = pk2(v1[0], v1[1]); o.w = pk2(v1[2], v1[3]);
                    *(u32x4*)(ho + off + bj * HALF) = o;
                    if constexpr (HN) { const f32x4 g0 = *(const f32x4*)(gain + c0 + bj * HALF), g1 = *(const f32x4*)(gain + c0 + bj * HALF + 4); u32x2 w8; w8.x = pk4_fp8(v0[0] * g0[0], v0[1] * g0[1], v0[2] * g0[2], v0[3] * g0[3]); w8.y = pk4_fp8(v1[0] * g1[0], v1[1] * g1[1], v1[2] * g1[2], v1[3] * g1[3]);
                        *(u32x2*)(hn8 + off + bj * HALF) = w8; } } }
            asm volatile("" ::: "memory");
        }
    }
};
struct EpiHid {
    static constexpr bool AFTER_DRAIN = false;
    const LAS float* rs;
    __device__ __forceinline__ void operator()(const Acc& acc, const Unit& u, int wr, int wc, int fr, int fq) const {
        unsigned char* base = (unsigned char*)u.o; int r0 = wr * 64 + fr; asm volatile("" : "+v"(r0)); const int c0 = wc * 32 + 8 * fq;
#pragma unroll
        for (int ai = 0; ai < 2; ++ai)
#pragma unroll
            for (int m = 0; m < 4; ++m) { unsigned char* rowp = base + (size_t)(r0 + ai * HALF + m * 16) * u.ldo + c0; float h[8]; const float rsv = rs[u.z * 256 + r0 + ai * HALF + m * 16] * (1.f / W_SCALE);
#pragma unroll
                for (int n = 0; n < 2; ++n)
#pragma unroll
                    for (int j = 0; j < 4; ++j) { const float g = acc[ai][0][m][n][j] * rsv, up = acc[ai][1][m][n][j] * (rsv * HID_SCALE); h[4 * n + j] = g * up / (1.f + __expf(-g)); }
                u32x2 w; w.x = pk4_fp8(h[0], h[1], h[2], h[3]); w.y = pk4_fp8(h[4], h[5], h[6], h[7]);
                *(u32x2*)rowp = w; }
    }
};
struct EpiSoftmax {
    static constexpr bool AFTER_DRAIN = true;
    const float* ssq; unsigned char* P;
    __device__ __forceinline__ void fused(Acc& acc, const Unit& u, int wr, int wc, int fr, int fq, LAS unsigned char* lds, int wid, int lane) const {
        LAS float* R1 = (LAS float*)lds; LAS float* R2 = (LAS float*)(lds + 4096);
#pragma unroll
        for (int ai = 0; ai < 2; ++ai)
#pragma unroll
            for (int m = 0; m < 4; ++m) { const int row = ai * HALF + wr * 64 + m * 16 + fr; const int grow = u.pm * 256 + row;
                const f32x4* sp = (const f32x4*)(ssq + (size_t)grow * 32); f32x4 t = sp[0];
#pragma unroll
                for (int i = 1; i < 8; ++i) t = t + sp[i];
                const float rstd = rsqrtf(((t[0] + t[1]) + (t[2] + t[3])) * (1.f / DM) + EPS) * (1.f / WQK_SCALE); float mx = -3.0e38f;
#pragma unroll
                for (int bj = 0; bj < 2; ++bj)
#pragma unroll
                    for (int n = 0; n < 2; ++n) { f32x4 v = acc[ai][bj][m][n] * rstd; acc[ai][bj][m][n] = v; mx = fmaxf(mx, fmaxf(fmaxf(v[0], v[1]), fmaxf(v[2], v[3]))); }
                mx = fmaxf(mx, __shfl_xor(mx, 16)); mx = fmaxf(mx, __shfl_xor(mx, 32));
                if (fq == 0) R1[row * 4 + wc] = mx; }
        __syncthreads();
#pragma unroll
        for (int ai = 0; ai < 2; ++ai)
#pragma unroll
            for (int m = 0; m < 4; ++m) { const int row = ai * HALF + wr * 64 + m * 16 + fr; const f32x4 q = *(const LAS f32x4*)(R1 + row * 4);
                const float M = fmaxf(fmaxf(q[0], q[1]), fmaxf(q[2], q[3])); float sm = 0.f;
#pragma unroll
                for (int bj = 0; bj < 2; ++bj)
#pragma unroll
                    for (int n = 0; n < 2; ++n) { f32x4 v = acc[ai][bj][m][n]; v[0] = __expf(v[0] - M); v[1] = __expf(v[1] - M); v[2] = __expf(v[2] - M); v[3] = __expf(v[3] - M); acc[ai][bj][m][n] = v; sm += (v[0] + v[1]) + (v[2] + v[3]); }
                sm += __shfl_xor(sm, 16); sm += __shfl_xor(sm, 32);
                if (fq == 0) R2[row * 4 + wc] = sm; }
        __syncthreads();
        const int c0 = u.pn * 256 + wc * 32 + 8 * fq;
#pragma unroll
        for (int ai = 0; ai < 2; ++ai)
#pragma unroll
            for (int m = 0; m < 4; ++m) { const int row = ai * HALF + wr * 64 + m * 16 + fr; const int grow = u.pm * 256 + row; const f32x4 q = *(const LAS f32x4*)(R2 + row * 4);
                const float inv = P_SCALE / ((q[0] + q[1]) + (q[2] + q[3]));
#pragma unroll
                for (int bj = 0; bj < 2; ++bj) { const f32x4 v0 = acc[ai][bj][m][0] * inv, v1 = acc[ai][bj][m][1] * inv;
                    u32x2 w; w.x = pk4_fp8(v0[0], v0[1], v0[2], v0[3]); w.y = pk4_fp8(v1[0], v1[1], v1[2], v1[3]);
                    *(u32x2*)(P + (size_t)grow * 1024 + c0 + bj * HALF) = w; } }
        __syncthreads();
    }
};
}
using pg8::Unit;


#define XB_TMO      128
#define XB_XCNT(j)  (256  + 64 * (j))
#define XB_XSUB(j)  (1280 + 64 * (j))
#define XB_XGEN(j)  (2304 + 64 * (j))
#define XB_TOP      3328
#define XB_TOPGEN   3392
#define XCD_BAR_WORDS 3456
#define XB_SPIN_CAP (1u << 22)
__device__ __forceinline__ unsigned xb_ld(unsigned* p)              { return __hip_atomic_load(p, __ATOMIC_RELAXED, __HIP_MEMORY_SCOPE_AGENT); }
__device__ __forceinline__ unsigned xb_add(unsigned* p, unsigned v) { return __hip_atomic_fetch_add(p, v, __ATOMIC_RELAXED, __HIP_MEMORY_SCOPE_AGENT); }
__device__ __forceinline__ unsigned xb_xcc_id() { return (unsigned)__builtin_amdgcn_s_getreg((3 << 11) | 20) & 0xFu; }
#define XB_SPIN(cond, bar) do { unsigned _sp = 0; while (cond) { __builtin_amdgcn_s_sleep(1); \
    if ((++_sp & 255u) == 0u) { if (xb_ld(&(bar)[XB_TMO])) break; if (_sp > XB_SPIN_CAP) { atomicAdd(&(bar)[XB_TMO], 1u); break; } } } } while (0)
struct XcdBarrier { unsigned* bar; unsigned x; volatile LAS unsigned* st; };
__device__ __forceinline__ XcdBarrier xcd_barrier_post(unsigned* bar, volatile LAS unsigned* st, bool leader) {
    XcdBarrier b; b.bar = bar; b.x = xb_xcc_id(); b.st = st;
    if (leader) (void)xb_add(&bar[XB_XCNT(b.x)], 1u);
    return b;
}
__device__ __forceinline__ void xcd_barrier_complete(unsigned* bar, unsigned x, unsigned& nloc, unsigned& nx) {
    const unsigned G = gridDim.x * gridDim.y * gridDim.z;
    unsigned sum, cnt, mine, sp = 0u;
    for (;;) {
        sum = 0u; cnt = 0u; mine = 0u;
#pragma unroll
        for (unsigned j = 0; j < 16; ++j) { const unsigned c = xb_ld(&bar[XB_XCNT(j)]); sum += c; cnt += (c > 0u) ? 1u : 0u; mine = (j == x) ? c : mine; }
        if (sum == G) break;
        __builtin_amdgcn_s_sleep(1);
        if ((++sp & 255u) == 0u) { if (xb_ld(&bar[XB_TMO])) break; if (sp > XB_SPIN_CAP) { atomicAdd(&bar[XB_TMO], 1u); break; } }
    }
    nloc = mine > 0u ? mine : 1u; nx = cnt > 0u ? cnt : 1u;
}
__device__ __forceinline__ void xcd_barrier(const XcdBarrier& b, int wave_) {
    asm volatile("s_waitcnt vmcnt(0)" ::: "memory");
    __syncthreads();
    if (wave_ == 0 && lane_id_v() == 0) {
        unsigned* bar = b.bar;
        __builtin_amdgcn_s_waitcnt(0);
        unsigned nloc = b.st[0], nx = b.st[1];
        if (nloc == 0u) { xcd_barrier_complete(bar, b.x, nloc, nx); b.st[0] = nloc; b.st[1] = nx; }
        const unsigned old = xb_add(&bar[XB_XSUB(b.x)], 1u);
        const unsigned gen = old / nloc;
        if (old + 1u == (gen + 1u) * nloc) {
            __builtin_amdgcn_fence(__ATOMIC_RELEASE, "agent");
            asm volatile("s_waitcnt vmcnt(0)" ::: "memory");
            const unsigned og = xb_add(&bar[XB_TOP], 1u);
            const unsigned tg = og / nx;
            if (og + 1u == (tg + 1u) * nx) xb_add(&bar[XB_TOPGEN], 1u);
            else XB_SPIN(xb_ld(&bar[XB_TOPGEN]) == tg, bar);
            __builtin_amdgcn_fence(__ATOMIC_ACQUIRE, "agent");
            xb_add(&bar[XB_XGEN(b.x)], 1u);
            asm volatile("s_waitcnt vmcnt(0)" ::: "memory");
        } else {
            XB_SPIN(xb_ld(&bar[XB_XGEN(b.x)]) == gen, bar);
            __builtin_amdgcn_fence(__ATOMIC_ACQUIRE, "agent");
            asm volatile("s_waitcnt vmcnt(0)" ::: "memory");
        }
    }
    __syncthreads();
}

struct Params {
    const float *x, *mem, *norm_mix, *w_in, *attn_out_norm, *sink_logit, *w_gla_gf, *b_gla_gf, *w_gla_gb, *b_gla_gb, *gla_out_norm, *w_out, *norm_cross, *norm_mem,
        *w_cq, *w_ck, *w_cv, *w_co, *norm_ffn, *w_rg, *b_rg, *w_re, *b_re, *w_gate, *w_up, *w_down, *norm_final;
    float* out; unsigned char* ws; int ph_lo, ph_hi;
};

template <class RowMap>
__device__ __forceinline__ void tr_item(const float* W, int N, int Nvalid, int k0, int n0, bf16_t* dst, int Kd, const RowMap& rm, LAS float* scr, int lane) {
    const bool ok = (n0 + lane) < Nvalid; const int nc = ok ? n0 + lane : Nvalid - 1; const float* src = W + (size_t)k0 * N + nc;
    float vv[64];
#pragma unroll
    for (int kk = 0; kk < 64; ++kk) vv[kk] = src[(size_t)kk * N];
#pragma unroll
    for (int kk = 0; kk < 64; ++kk) scr[kk * 65 + lane] = ok ? vv[kk] : 0.f;
    asm volatile("s_waitcnt lgkmcnt(0)" ::: "memory");
    const int c = lane & 7;
#pragma unroll
    for (int j = 0; j < 8; ++j) { const int n = (lane >> 3) + 8 * j; const LAS float* s = scr + (8 * c) * 65 + n;
        u32x4 o; o.x = pk2(s[0], s[65]); o.y = pk2(s[2 * 65], s[3 * 65]); o.z = pk2(s[4 * 65], s[5 * 65]); o.w = pk2(s[6 * 65], s[7 * 65]);
        *(u32x4*)(dst + (size_t)rm(n0 + n) * Kd + k0 + 8 * c) = o; }
    asm volatile("s_waitcnt lgkmcnt(0)" ::: "memory");
}
template <class RowMap>
__device__ __forceinline__ void tr_item8(const float* W, int N, int k0, int n0, unsigned char* dst, int Kd, const RowMap& rm, float scale, LAS float* scr, int lane, bool nostore = false) {
    LAS unsigned* s32 = (LAS unsigned*)scr;
    {
        const int n4 = lane & 15, ks = lane >> 4; const float* src = W + (size_t)(k0 + 2 * ks) * N + n0 + 4 * n4;
        f32x4 va[16], vb[16];
#pragma unroll
        for (int i = 0; i < 16; ++i) { va[i] = __builtin_nontemporal_load((const f32x4*)(src + (size_t)(8 * i) * N)); vb[i] = __builtin_nontemporal_load((const f32x4*)(src + (size_t)(8 * i + 1) * N)); }
#pragma unroll
        for (int i = 0; i < 16; ++i)
#pragma unroll
            for (int e = 0; e < 4; ++e) s32[(4 * i + ks) * 65 + 4 * n4 + e] = pk2(va[i][e], vb[i][e]); }
    asm volatile("s_waitcnt lgkmcnt(0)" ::: "memory");
    const int c = lane & 7;
#pragma unroll
    for (int j = 0; j < 8; ++j) { const int n = (lane >> 3) + 8 * j; const LAS unsigned* s = s32 + (8 * c) * 65 + n; unsigned w[8];
#pragma unroll
        for (int i = 0; i < 8; ++i) w[i] = s[i * 65];
        u32x4 o;
        o.x = pk4_fp8(bflo(w[0]) * scale, bfhi(w[0]) * scale, bflo(w[1]) * scale, bfhi(w[1]) * scale); o.y = pk4_fp8(bflo(w[2]) * scale, bfhi(w[2]) * scale, bflo(w[3]) * scale, bfhi(w[3]) * scale);
        o.z = pk4_fp8(bflo(w[4]) * scale, bfhi(w[4]) * scale, bflo(w[5]) * scale, bfhi(w[5]) * scale); o.w = pk4_fp8(bflo(w[6]) * scale, bfhi(w[6]) * scale, bflo(w[7]) * scale, bfhi(w[7]) * scale);
        if (!nostore || (o.x == 0x12345678u && o.y == 0x9abcdef0u)) __builtin_nontemporal_store(o, (u32x4*)(dst + (size_t)rm(n0 + n) * Kd + k0 + 16 * c)); }
    asm volatile("s_waitcnt lgkmcnt(0)" ::: "memory");
}
struct RmId { int off; __device__ __forceinline__ int operator()(int n) const { return off + n; } };
struct RmGu { int base; __device__ __forceinline__ int operator()(int n) const { return base + (n >> 7) * 256 + (n & 127); } };

struct SchedP1 {
    int G, c; const char *u, *win, *memn, *wckv; char *proj, *memK, *memV;
    __device__ __forceinline__ bool next(int i, Unit& t) const {
        int L = i * G + c;
        if (L < 1216) { int pm, pn; pg8::tile_map(L, 64, 19, pm, pn); t.a = u + (size_t)pm * 256 * DM * 2; t.b = win + (size_t)pn * 256 * DM * 2; t.o = proj + ((size_t)pm * 256 * PLD + pn * 256) * 2; t.pm = pm; t.pn = pn; t.ldo = PLD; t.z = 1; return true; }
        L -= 1216; if (L >= 64) return false;
        const int pm = L & 3, pn = L >> 2; t.a = memn + (size_t)pm * 256 * DM * 2; t.b = wckv + (size_t)pn * 256 * DM * 2;
        t.o = (pn < 8 ? memK : memV) + ((size_t)pm * 256 * DM + (pn & 7) * 256) * 2; t.pm = pm; t.pn = pn; t.ldo = DM; t.z = 1; return true;
    }
};
struct SchedPre {
    int G, c; const char *memK, *memV, *wcq, *wco; char *wqk, *wvo;
    __device__ __forceinline__ bool next(int i, Unit& t) const {
        int L = i * G + c; if (L >= 256 * PRE_REP) return false;
        L &= 255;
        const int q = L & 127, b = q >> 5, h = (q >> 3) & 3, ct = q & 7;
        if (L < 128) { t.a = memK + ((size_t)b * 256 * DM + h * 512) * 2; t.b = wcq + ((size_t)ct * 256 * DM + h * 512) * 2; t.o = wqk + (((size_t)b * 1024 + h * 256) * DM + ct * 256); t.pm = 0; t.pn = ct; t.ldo = DM; t.z = 0; }
        else { t.a = wco + ((size_t)ct * 256 * DM + h * 512) * 2; t.b = memV + ((size_t)b * 256 * DM + h * 512) * 2; t.o = wvo + (((size_t)b * 2048 + ct * 256) * 1024 + h * 256); t.pm = 0; t.pn = 0; t.ldo = 1024; t.z = 1; }
        return true;
    }
};
struct SchedTok {
    int G, c, nN; const char *A, *B; size_t astride  , bstride_tile  , bstride_batch;
    __device__ __forceinline__ bool next(int i, Unit& t) const {
        const int L = i * G + c; if (L >= 64 * nN) return false;
        int pm, pn; pg8::tile_map(L, 64, nN, pm, pn);
        t.a = A + (size_t)pm * astride; t.b = B + (size_t)(pm >> 4) * bstride_batch + (size_t)pn * bstride_tile; t.o = nullptr; t.pm = pm; t.pn = pn; t.ldo = 0; t.z = 0; return true;
    }
};
struct SchedOne { Unit u0; __device__ __forceinline__ bool next(int i, Unit& t) const { if (i > 0) return false; t = u0; return true; } };
struct SchedMoe {
    const LAS int* T; const int* list; const float* rstd3; LAS float* rs;
    int G, c, nblk; const LAS int* blk_e; const char *A, *B; char* O; size_t astride, bexp, btile, ostride; int ocol  , ldo, reps;
    __device__ __forceinline__ bool next(int i, Unit& t) const {
        int L = i * G + c; if (L >= nblk * 8 * reps) return false;
        if (L >= nblk * 8) L -= nblk * 8;
        int pm, pn; pg8::tile_map(L, nblk, 8, pm, pn); const int e = __builtin_amdgcn_readfirstlane(blk_e[pm]);
        t.a = A + (size_t)pm * astride; t.b = B + (size_t)e * bexp + (size_t)pn * btile; t.o = O + (size_t)pm * ostride + (size_t)pn * ocol; t.pm = pm; t.pn = pn; t.ldo = ldo; t.z = list ? i % 3 : 1; return true;
    }
    __device__ __forceinline__ int rowtok(const Unit& u, int r) const { const int e = __builtin_amdgcn_readfirstlane(blk_e[u.pm]); const int idx = (u.pm - __builtin_amdgcn_readfirstlane(T[1 + e])) * 256 + r; const int cnt = __builtin_amdgcn_readfirstlane(T[240 + e]);
        return idx < cnt ? list[e * 16384 + idx] : 0; }
    __device__ __forceinline__ void rs_fill(const Unit& u, int tid) const { if (tid < 256) rs[u.z * 256 + tid] = rstd3[rowtok(u, tid)]; }
};

__device__ __forceinline__ void moe_table(const unsigned* cnt, LAS int* T, int tid_) {
    if (tid_ == 0) { int acc = 0;
        for (int e = 0; e < NEXP; ++e) { T[1 + e] = acc; T[240 + e] = (int)cnt[e]; const int nb = ((int)cnt[e] + 255) >> 8; for (int j = 0; j < nb; ++j) T[64 + acc + j] = e; acc += nb; }
        T[1 + NEXP] = acc; T[0] = acc; }
    __syncthreads();
}

__global__ void __launch_bounds__(512, 2) fwd_mega(Params p) {
    extern __shared__ __attribute__((aligned(16))) unsigned char lds_raw[];
    LAS unsigned char* lds = (LAS unsigned char*)lds_raw;
    const unsigned ldsb = (unsigned)(size_t)lds;
    const int wave = __builtin_amdgcn_readfirstlane((int)threadIdx.x >> 6);
#define PH_IDS const int lane = lane_id_v(), tid = wave * 64 + lane; (void)tid; (void)lane;
    const int G = gridDim.x, bid = blockIdx.x;
    const int gw = bid * 8 + wave, NGW = G * 8;
    unsigned char* const ws = p.ws;
#define WGU ((unsigned char*)(ws + WS_WGU))
#define WD ((unsigned char*)(ws + WS_WD))
#define WIN ((bf16_t*)(ws + WS_WIN))
#define WCKV ((bf16_t*)(ws + WS_WCKV))
#define WOUT ((bf16_t*)(ws + WS_WOUT))
#define WCO ((bf16_t*)(ws + WS_WCO))
#define WCQ ((bf16_t*)(ws + WS_WCQ))
#define WQK ((unsigned char*)(ws + WS_WQK))
#define WVO ((unsigned char*)(ws + WS_WVO))
#define U ((bf16_t*)(ws + WS_U))
#define H1B ((bf16_t*)(ws + WS_H1B))
#define H1F8 ((unsigned char*)(ws + WS_H1F8))
#define HN8 ((unsigned char*)(ws + WS_H1F8))
#define LIST ((int*)(ws + WS_FIMG))
#define MEMN ((bf16_t*)(ws + WS_MEMN))
#define MEMK ((bf16_t*)(ws + WS_MEMK))
#define MEMV ((bf16_t*)(ws + WS_MEMV))
#define PROJ ((bf16_t*)(ws + WS_PROJ))
#define PB ((unsigned char*)(ws + WS_P))
#define GQ ((bf16_t*)(ws + WS_GQ))
#define GK ((bf16_t*)(ws + WS_GK))
#define GD ((float*)(ws + WS_GD))
#define O1 ((bf16_t*)(ws + WS_O1))
#define O2 ((bf16_t*)(ws + WS_O2))
#define O3 ((bf16_t*)(ws + WS_O3))
#define A2 ((bf16_t*)(ws + WS_A2))
#define SSQ ((float*)(ws + WS_SSQ))
#define XS ((unsigned char*)(ws + WS_XS))
#define HID ((unsigned char*)(ws + WS_HID))
#define YS ((unsigned char*)(ws + WS_YS))
#define WR ((float*)(ws + WS_WR))
#define FIMG ((float*)(ws + WS_FIMG))
#define SEGD ((float*)(ws + WS_SEGD))
#define ASG_E ((int*)(ws + WS_ASG))
#define ASG_S (ASG_E + 2 * NT)
#define ASG_G ((float*)(ASG_S + 2 * NT))
#define RSTD3 (ASG_G + 2 * NT)
#define DEST ((int*)(RSTD3 + NT))
#define CNT ((unsigned*)(ws + WS_CTL) + CW_CNT)
    float* H = p.out;
    LAS int* TBL = (LAS int*)(lds + MISC_OFF);
    const int lo = p.ph_lo, hi = p.ph_hi;
#define IN(k) (lo <= (k) && (k) < hi)
    volatile LAS unsigned* XST = (volatile LAS unsigned*)(lds + MISC_OFF + 4096);
    { PH_IDS if (tid < 4) XST[tid] = 0u;
    __syncthreads();
    }
    XcdBarrier xbar; { PH_IDS xbar = xcd_barrier_post((unsigned*)(ws + WS_CTL) + CW_BAR, XST, tid == 0); }
#define SEAM(k) do { if (IN(k) && IN((k) + 1)) xcd_barrier(xbar, wave); } while (0)

    if (IN(0)) for (int rp_ = 0; rp_ < (RPT == 0 ? 2 : 1); ++rp_) { PH_IDS
        LAS float* scr = (LAS float*)(lds + wave * 16640);
        constexpr int I_IN = 32 * 76, I_SQ = 32 * 32, I_G = 16 * 16, I_D = 8 * 32;
        for (int it = gw; it < (I_IN + 2 * I_SQ) * P0T_REP; it += NGW) {
            int r = it % (I_IN + 2 * I_SQ);
            if (r < I_IN) { const int kb = r / 76, nb = r % 76; tr_item(p.w_in, 4640, 4640, 64 * kb, 64 * nb, WIN, DM, RmId{0}, scr, lane); continue; } r -= I_IN;
            if (r < I_SQ) { tr_item(p.w_ck, DM, DM, 64 * (r >> 5), 64 * (r & 31), WCKV, DM, RmId{0}, scr, lane); continue; } r -= I_SQ;
            tr_item(p.w_cv, DM, DM, 64 * (r >> 5), 64 * (r & 31), WCKV, DM, RmId{2048}, scr, lane);
        }
        {
            f32x4 cv[8], n1[8], n2[8];
            constexpr int NR = NT + NB * MEML;
            auto rowp = [&](int m) -> const f32x4* { return (const f32x4*)(m < NT ? p.x + (size_t)m * DM : p.mem + (size_t)(m - NT) * DM) + 2 * lane; };
            auto rload = [&](int m, f32x4 (&d)[8]) { const f32x4* xr = rowp(m < NR ? m : gw);
#pragma unroll
                for (int j = 0; j < 4; ++j) { d[2 * j] = xr[128 * j]; d[2 * j + 1] = xr[128 * j + 1]; } };
            for (int prr = 0; prr < P0R_REP; ++prr) {
            if (gw < NR) { rload(gw, cv); rload(gw + NGW, n1); }
            for (int m = gw; m < NR; m += NGW) {
                rload(m + 2 * NGW, n2);
                float s = 0.f;
#pragma unroll
                for (int j = 0; j < 8; ++j) s += (cv[j][0] * cv[j][0] + cv[j][1] * cv[j][1]) + (cv[j][2] * cv[j][2] + cv[j][3] * cv[j][3]);
                const float rstd = rsqrtf(wave_sum(s) * (1.f / DM) + EPS);
                const f32x4* gr = (const f32x4*)(m < NT ? p.norm_mix : p.norm_mem) + 2 * lane; u32x4* o = (u32x4*)(m < NT ? U + (size_t)m * DM : MEMN + (size_t)(m - NT) * DM) + lane;
#pragma unroll
                for (int j = 0; j < 4; ++j) { const f32x4 g0 = gr[128 * j], g1 = gr[128 * j + 1]; const f32x4 a = cv[2 * j], c = cv[2 * j + 1]; u32x4 w;
                    w.x = pk2(a[0] * rstd * g0[0], a[1] * rstd * g0[1]); w.y = pk2(a[2] * rstd * g0[2], a[3] * rstd * g0[3]); w.z = pk2(c[0] * rstd * g1[0], c[1] * rstd * g1[1]); w.w = pk2(c[2] * rstd * g1[2], c[3] * rstd * g1[3]);
                    o[64 * j] = w; }
#pragma unroll
                for (int j = 0; j < 8; ++j) { cv[j] = n1[j]; n1[j] = n2[j]; }
            }
            }
        }
        __syncthreads();
    }
    SEAM(0);

    if (IN(1)) for (int rp_ = 0; rp_ < (RPT == 1 ? 2 : 1); ++rp_) { PH_IDS
        SchedP1 S{G, bid, (const char*)U, (const char*)WIN, (const char*)MEMN, (const char*)WCKV, (char*)PROJ, (char*)MEMK, (char*)MEMV};
        pg8::EpiStore E{nullptr, 1.f};
        LAS float* scr = (LAS float*)(lds + wave * 16640);
        constexpr int I_G = 16 * 16, I_D = 8 * 32, NE = NEXP * (2 * I_G + I_D);
        int kdone = 0; const int ktot = (NE * (1 + P0E_REP) - gw + NGW - 1) / NGW;
        struct EDesc { const float* W; unsigned char* dst; int N, Kd, k0, n0, rb, gu; };
        auto edesc = [&](int it) { EDesc d; const int q = it % NE; const int typ = q / (NEXP * 256), e = NEXP - 1 - (q % (NEXP * 256)) / 256, r = q % 256;
            if (typ == 0) { d.W = p.w_down + (size_t)e * DFF * DM; d.N = DM; d.k0 = 128 * (r >> 5); d.n0 = 64 * (r & 31); d.dst = WD + (size_t)e * 2048 * DFF; d.Kd = DFF; d.rb = 0; d.gu = 0; }
            else { d.W = (typ == 1 ? p.w_up : p.w_gate) + (size_t)e * DM * DFF; d.N = DFF; d.k0 = 128 * (r >> 4); d.n0 = 64 * (r & 15); d.dst = WGU + (size_t)e * 2048 * DM; d.Kd = DM; d.rb = (typ == 1) ? 128 : 0; d.gu = 1; }
            return d; };
        auto prep_chunk = [&](int nitems) {
            LAS unsigned* s32 = (LAS unsigned*)scr; const int n4 = lane & 15, ks = lane >> 4, cc = lane & 7;
            int left = ktot - kdone; if (left > nitems) left = nitems;
            if (left > 0) {
                f32x4 va[16], vb[16];
                auto eload = [&](const EDesc& d) { const float* sp = d.W + (size_t)(d.k0 + 2 * ks) * d.N + d.n0 + 4 * n4;
#pragma unroll
                    for (int i = 0; i < 16; ++i) { va[i] = __builtin_nontemporal_load((const f32x4*)(sp + (size_t)(8 * i) * d.N)); vb[i] = __builtin_nontemporal_load((const f32x4*)(sp + (size_t)(8 * i + 1) * d.N)); } };
                EDesc dcur = edesc(gw + kdone * NGW); eload(dcur);
                for (int c = 0; c < left; ++c, ++kdone) {
#pragma unroll
                    for (int i = 0; i < 16; ++i)
#pragma unroll
                        for (int e = 0; e < 4; ++e) s32[(4 * i + ks) * 65 + 4 * n4 + e] = pk2(va[i][e], vb[i][e]);
                    asm volatile("s_waitcnt lgkmcnt(0)" ::: "memory");
                    EDesc dnext = dcur; if (c + 1 < left) { dnext = edesc(gw + (kdone + 1) * NGW); eload(dnext); }
#pragma unroll
                    for (int j = 0; j < 8; ++j) { const int n = (lane >> 3) + 8 * j; const LAS unsigned* s = s32 + (8 * cc) * 65 + n; unsigned w[8];
#pragma unroll
                        for (int i = 0; i < 8; ++i) w[i] = s[i * 65];
                        u32x4 o;
                        o.x = pk4_fp8(bflo(w[0]) * W_SCALE, bfhi(w[0]) * W_SCALE, bflo(w[1]) * W_SCALE, bfhi(w[1]) * W_SCALE); o.y = pk4_fp8(bflo(w[2]) * W_SCALE, bfhi(w[2]) * W_SCALE, bflo(w[3]) * W_SCALE, bfhi(w[3]) * W_SCALE);
                        o.z = pk4_fp8(bflo(w[4]) * W_SCALE, bfhi(w[4]) * W_SCALE, bflo(w[5]) * W_SCALE, bfhi(w[5]) * W_SCALE); o.w = pk4_fp8(bflo(w[6]) * W_SCALE, bfhi(w[6]) * W_SCALE, bflo(w[7]) * W_SCALE, bfhi(w[7]) * W_SCALE);
                        const int nn = dcur.n0 + n; const int row = dcur.gu ? dcur.rb + (nn >> 7) * 256 + (nn & 127) : nn;
                        if (!(P0E_NOSTORE && gw + kdone * NGW >= NE) || o.x == 0x12345678u) __builtin_nontemporal_store(o, (u32x4*)(dcur.dst + (size_t)row * dcur.Kd + dcur.k0 + 16 * cc)); }
                    asm volatile("s_waitcnt lgkmcnt(0)" ::: "memory");
                    dcur = dnext; } }
            __syncthreads(); };
        auto extra_prep = [&]() {
            constexpr int I_SQ = 32 * 32;
            for (int it = gw; it < 2 * I_SQ; it += NGW) { const int r = it & (I_SQ - 1);
                if (it < I_SQ) tr_item(p.w_out, DM, DM, 64 * (r >> 5), 64 * (r & 31), WOUT, DM, RmId{0}, scr, lane); else tr_item(p.w_co, DM, DM, 64 * (r >> 5), 64 * (r & 31), WCO, DM, RmId{0}, scr, lane); }
        for (int i = gw * 64 + lane; i < DM * DM / 8; i += NGW * 64) { const f32x4 a = ((const f32x4*)p.w_cq)[2 * i], b = ((const f32x4*)p.w_cq)[2 * i + 1];
            u32x4 w; w.x = pk2(a[0], a[1]); w.y = pk2(a[2], a[3]); w.z = pk2(b[0], b[1]); w.w = pk2(b[2], b[3]); ((u32x4*)WCQ)[i] = w; }
        for (int i = gw * 64 + lane; i < 128 * 3 * 64; i += NGW * 64) { const int l = i & 63, ct = (i >> 6) % 3, kb = i / 192; const int j = 16 * ct + (l & 15); f32x4 o;
#pragma unroll
            for (int e = 0; e < 4; ++e) { const int k = 16 * kb + 4 * (l >> 4) + e; float w = 0.f; if (j < 4) w = p.w_rg[k * 4 + j]; else if (j < 36) w = p.w_re[k * 32 + (j - 4)]; o[e] = w * p.norm_ffn[k]; }
            ((f32x4*)WR)[i] = o; }
            __syncthreads(); };
        int nun = 0; { Unit t; while (S.next(nun, t)) ++nun; }
        const int per = nun > 0 ? (ktot + nun - 1) / nun : ktot;
        if (bid & 1) { extra_prep(); prep_chunk(per); }
        for (int i = 0; i < nun; ++i) { SchedOne S1; S.next(i, S1.u0);
            pg8::gemm_phase<pg8::EpiStore, SchedOne, false>(lds, DM * 2, DM / 64, S1, E, wave);
            if (i == 0 && !(bid & 1)) extra_prep();
            prep_chunk(per); }
        if (nun == 0 && !(bid & 1)) extra_prep();
        prep_chunk(ktot);
    }
    SEAM(1);

    if (IN(2)) for (int rp_ = 0; rp_ < (RPT == 2 ? 2 : 1); ++rp_) { PH_IDS }

    if (IN(3)) for (int rp_ = 0; rp_ < (RPT == 3 ? 2 : 1); ++rp_) { PH_IDS
        const int r32 = lane & 31, hh = lane >> 5, q4 = (lane & 15) >> 2, p4 = lane & 3, blk = (lane >> 4) & 1;
        {
            constexpr int L_B = 0, L_Q = 32768, L_KI = L_Q + 17408, L_KD = L_KI + 17408, L_V = L_KD + 17408, L_P = L_V + 33792, L_TT = L_P + 9216, L_D = L_TT + 1024;
            static_assert(L_D + 512 <= MISC_OFF, "G1 LDS");
            LAS float* BB_ = (LAS float*)(lds + L_B); LAS float* TT = (LAS float*)(lds + L_TT); LAS float* DD = (LAS float*)(lds + L_D);
            const int gct = wave & 1, gdt = wave >> 1;
            for (int it0 = bid; it0 < 256 * SCAN_REP; it0 += G) { const int it = it0 & 255;
                const int dir = it & 1, h = (it >> 1) & 3, b = (it >> 3) & 3, sg = it >> 5; const int vs = wave;
                const size_t tile0 = (size_t)((b * 4 + h) * 2 + dir) * 64; bf16_t* OUT = dir ? O3 : O2;
                f32x16 St[4];
#pragma unroll
                for (int db = 0; db < 4; ++db)
#pragma unroll
                    for (int i = 0; i < 16; ++i) St[db][i] = 0.f;
                bf16x8 bw; float gbias;
                { const float* wgp = (dir ? p.w_gla_gb : p.w_gla_gf) + h * 128 + 32 * gdt + r32; float wg8[8];
#pragma unroll
                  for (int j = 0; j < 8; ++j) wg8[j] = wgp[(8 * hh + j) * 512];
                  bw = pack8(wg8); gbias = (dir ? p.b_gla_gb : p.b_gla_gf)[h * 128 + 32 * gdt + r32]; }
                float segp = 1.f;
                bf16x8 n_alr, n_pq[2], n_pk[2], n_pv[4];
                auto cload = [&](int n_) { const int t0_ = b * SEQ + n_ * 64;
                    n_alr = *(const bf16x8*)(PROJ + (size_t)(t0_ + 32 * gct + r32) * PLD + C_LRF + 16 * dir + 8 * hh);
#pragma unroll
                    for (int rep = 0; rep < 2; ++rep) { const int pidx = tid + 512 * rep, c = pidx >> 4, d8 = (pidx & 15) * 8; const size_t rowoff = (size_t)(t0_ + c) * PLD + h * 128 + d8;
                        n_pq[rep] = *(const bf16x8*)(PROJ + rowoff + C_QG); n_pk[rep] = *(const bf16x8*)(PROJ + rowoff + C_KG); }
#pragma unroll
                    for (int rep = 0; rep < 4; ++rep) { const int pidx = tid + 512 * rep, row = pidx >> 5, ch = pidx & 31; n_pv[rep] = *(const bf16x8*)(PROJ + (size_t)(t0_ + row) * PLD + C_VG + h * 256 + ch * 8); } };
                cload(dir ? 63 - 8 * sg : 8 * sg);
                for (int i8 = 0; i8 < 8; ++i8) {
                    const int i = 8 * sg + i8; const int n = dir ? 63 - i : i; const int t0 = b * SEQ + n * 64;
                    { f32x16 z;
#pragma unroll
                      for (int q = 0; q < 16; ++q) z[q] = 0.f;
                      f32x16 Gt = MFMA32(n_alr, bw, z);
#pragma unroll
                      for (int q = 0; q < 16; ++q) { const float pre = Gt[q] + gbias; Gt[q] = (fminf(pre, 0.f) - __logf(1.f + __expf(-fabsf(pre)))) * (1.f / 16.f); }
                      float T[4], Uo[4], off[4]; float run = 0.f;
                      if (dir == 0) {
#pragma unroll
                          for (int g = 0; g < 4; ++g) { Gt[4 * g + 1] += Gt[4 * g]; Gt[4 * g + 2] += Gt[4 * g + 1]; Gt[4 * g + 3] += Gt[4 * g + 2]; T[g] = Gt[4 * g + 3]; }
                      } else {
#pragma unroll
                          for (int g = 0; g < 4; ++g) { Gt[4 * g + 2] += Gt[4 * g + 3]; Gt[4 * g + 1] += Gt[4 * g + 2]; Gt[4 * g] += Gt[4 * g + 1]; T[g] = Gt[4 * g]; }
                      }
#pragma unroll
                      for (int g = 0; g < 4; ++g) Uo[g] = __shfl_xor(T[g], 32);
                      if (dir == 0) {
#pragma unroll
                          for (int g = 0; g < 4; ++g) { off[g] = run + (hh ? Uo[g] : 0.f); run += T[g] + Uo[g]; }
                      } else {
#pragma unroll
                          for (int g = 3; g >= 0; --g) { off[g] = run + (hh ? 0.f : Uo[g]); run += T[g] + Uo[g]; }
                      }
                      const int dcol = 32 * gdt + r32;
#pragma unroll
                      for (int q = 0; q < 16; ++q) BB_[(32 * gct + crow(q, hh)) * 128 + dcol] = Gt[q] + off[q >> 2];
                      if (hh == 0) TT[gct * 128 + dcol] = run; }
                    lds_barrier();
#pragma unroll
                    for (int rep = 0; rep < 2; ++rep) { const int pidx = tid + 512 * rep, c = pidx >> 4, d8 = (pidx & 15) * 8;
                        float q[8], k[8]; unpack8(n_pq[rep], q); unpack8(n_pk[rep], k);
                        const LAS float* Bd = BB_ + c * 128 + d8; const f32x4 b0 = *(const LAS f32x4*)Bd, b1 = *(const LAS f32x4*)(Bd + 4);
                        const f32x4 ta0 = *(const LAS f32x4*)(TT + d8), ta1 = *(const LAS f32x4*)(TT + d8 + 4), tb0 = *(const LAS f32x4*)(TT + 128 + d8), tb1 = *(const LAS f32x4*)(TT + 128 + d8 + 4);
                        const bool fix = dir ? (c < 32) : (c >= 32);
                        float qd[8], ki[8], kd[8];
#pragma unroll
                        for (int j = 0; j < 8; ++j) { const float t0v = j < 4 ? ta0[j] : ta1[j - 4], t1v = j < 4 ? tb0[j] : tb1[j - 4]; const float bb = (j < 4 ? b0[j] : b1[j - 4]) + (fix ? (dir ? t1v : t0v) : 0.f);
                            const float e = __expf(bb); qd[j] = q[j] * 0.08838834764831845f * e; ki[j] = k[j] * __expf(-bb); kd[j] = k[j] * __expf((t0v + t1v) - bb); }
                        const bf16x8 qv = pack8(qd);
                        *(LAS bf16x8*)(lds + L_Q + c * 272 + d8 * 2) = qv; *(LAS bf16x8*)(lds + L_KI + c * 272 + d8 * 2) = pack8(ki); *(LAS bf16x8*)(lds + L_KD + c * 272 + d8 * 2) = pack8(kd);
                        *(bf16x8*)(GQ + ((tile0 + n) * 64 + c) * 128 + d8) = qv; }
#pragma unroll
                    for (int rep = 0; rep < 4; ++rep) { const int pidx = tid + 512 * rep, row = pidx >> 5, ch = pidx & 31; *(LAS bf16x8*)(lds + L_V + row * 528 + ch * 16) = n_pv[rep]; }
                    if (i8 + 1 < 8) cload(dir ? n - 1 : n + 1);
                    if (tid < 128) { const float dec = __expf(TT[tid] + TT[128 + tid]); DD[tid] = dec; GD[(tile0 + n) * 128 + tid] = dec; segp *= dec; }
                    lds_barrier();
                    if (wave < 4) { const int st = wave >> 1, ct = wave & 1; f32x16 x;
#pragma unroll
                        for (int q = 0; q < 16; ++q) x[q] = 0.f;
#pragma unroll
                        for (int ks = 0; ks < 8; ++ks) { const bf16x8 ak = *(const LAS bf16x8*)(lds + L_KI + (32 * st + r32) * 272 + (16 * ks + 8 * hh) * 2), bq = *(const LAS bf16x8*)(lds + L_Q + (32 * ct + r32) * 272 + (16 * ks + 8 * hh) * 2);
                            x = MFMA32(ak, bq, x); }
                        const int cpos = 32 * ct + r32;
#pragma unroll
                        for (int g = 0; g < 4; ++g) { float m4[4];
#pragma unroll
                            for (int j = 0; j < 4; ++j) { const int s = 32 * st + 8 * g + 4 * hh + j; const bool keep = dir ? (s >= cpos) : (s <= cpos); m4[j] = keep ? x[4 * g + j] : 0.f; }
                            u32x2 w; w.x = pk2(m4[0], m4[1]); w.y = pk2(m4[2], m4[3]); *(LAS u32x2*)(lds + L_P + cpos * 144 + (32 * st + 8 * g + 4 * hh) * 2) = w; } }
                    lds_barrier();
                    { f32x16 o[2];
#pragma unroll
                      for (int ct = 0; ct < 2; ++ct)
#pragma unroll
                          for (int j = 0; j < 16; ++j) o[ct][j] = 0.f;
#pragma unroll
                      for (int kk = 0; kk < 4; ++kk) { const unsigned va = ldsb + L_V + (16 * kk + 8 * hh + q4) * 528 + (32 * vs + 16 * blk + 4 * p4) * 2; const bf16x8 av = tr_read2(va, va + 4 * 528);
#pragma unroll
                          for (int ct = 0; ct < 2; ++ct) { const bf16x8 bp = *(const LAS bf16x8*)(lds + L_P + (32 * ct + r32) * 144 + (16 * kk + 8 * hh) * 2); o[ct] = MFMA32(av, bp, o[ct]); } }
#pragma unroll
                      for (int db = 0; db < 4; ++db)
#pragma unroll
                          for (int s = 0; s < 2; ++s) { const bf16x8 xs = pack_step(St[db], s);
#pragma unroll
                              for (int ct = 0; ct < 2; ++ct) { const LAS unsigned char* qp = lds + L_Q + (32 * ct + r32) * 272 + (32 * db + 16 * s + 4 * hh) * 2;
                                  const s16x4 lo4 = *(const LAS s16x4*)qp, hi4 = *(const LAS s16x4*)(qp + 16); const bf16x8 bq = __builtin_shufflevector(lo4, hi4, 0, 1, 2, 3, 4, 5, 6, 7);
                                  o[ct] = MFMA32(xs, bq, o[ct]); } }
#pragma unroll
                      for (int ct = 0; ct < 2; ++ct) { bf16_t* orow = OUT + (size_t)(t0 + 32 * ct + r32) * 1024 + h * 256 + 32 * vs + 4 * hh;
#pragma unroll
                          for (int g = 0; g < 4; ++g) { u32x2 w; w.x = pk2(o[ct][4 * g], o[ct][4 * g + 1]); w.y = pk2(o[ct][4 * g + 2], o[ct][4 * g + 3]); *(u32x2*)(orow + 8 * g) = w; } } }
#pragma unroll
                    for (int db = 0; db < 4; ++db) {
#pragma unroll
                        for (int g = 0; g < 4; ++g) { const f32x4 dv = *(const LAS f32x4*)(DD + 32 * db + 8 * g + 4 * hh);
#pragma unroll
                            for (int j = 0; j < 4; ++j) St[db][4 * g + j] *= dv[j]; } }
#pragma unroll
                    for (int kk = 0; kk < 4; ++kk) { bf16x8 bv, ak[4];
                        tr_scan10(ldsb + L_V + (16 * kk + 8 * hh + q4) * 528 + (32 * vs + 16 * blk + 4 * p4) * 2, ldsb + L_KD + (16 * kk + 8 * hh + q4) * 272 + (16 * blk + 4 * p4) * 2, bv, ak);
#pragma unroll
                        for (int db = 0; db < 4; ++db) St[db] = MFMA32(ak[db], bv, St[db]); }
                    lds_barrier();
                }
                float* fi = FIMG + ((size_t)(it * 8 + wave) * 64) * 64 + lane;
#pragma unroll
                for (int db = 0; db < 4; ++db)
#pragma unroll
                    for (int r = 0; r < 16; ++r) fi[(db * 16 + r) * 64] = St[db][r];
                if (tid < 128) SEGD[it * 128 + tid] = segp;
            }
            lds_barrier();
        }
        {
            constexpr int A_K = 0, A_V = 33792, A_SS = 67584;
            for (int it0 = bid; it0 < NB * (SEQ / 32) * ATT_REP; it0 += G) { const int it = it0 & 511;
                const int b = it >> 7, qb = it & 127, q0 = qb * 32; const int hq = wave, kvh = wave >> 2;
                const float slope = exp2f(-(float)(hq + 1)); const float sink = p.sink_logit[hq];
                bf16x8 qf[8];
#pragma unroll
                for (int s = 0; s < 8; ++s) qf[s] = *(const bf16x8*)(PROJ + (size_t)(b * SEQ + q0 + r32) * PLD + C_QA + hq * 128 + 16 * s + 8 * hh);
                f32x16 ot[4];
#pragma unroll
                for (int dt = 0; dt < 4; ++dt)
#pragma unroll
                    for (int i = 0; i < 16; ++i) ot[dt][i] = 0.f;
                float mrun = sink, lrun = 1.f; const int qpos = q0 + r32;
                int ktlo = 0, kthi = 4;
                while (q0 - 128 + 64 * ktlo + 63 < 0) ++ktlo;
                while (q0 - 128 + 64 * kthi >= SEQ) --kthi;
                bf16x8 pk_[4], pv_[4];
                auto kvload = [&](int kt) { const int k0 = q0 - 128 + 64 * kt;
#pragma unroll
                    for (int rep = 0; rep < 4; ++rep) { const int pidx = tid + 512 * rep, row = pidx >> 5, ch = pidx & 31; int kp = k0 + row; kp = kp < 0 ? 0 : (kp >= SEQ ? SEQ - 1 : kp);
                        const bf16_t* src = PROJ + (size_t)(b * SEQ + kp) * PLD; pk_[rep] = *(const bf16x8*)(src + C_KA + ch * 8); pv_[rep] = *(const bf16x8*)(src + C_VA + ch * 8); } };
                kvload(ktlo);
                for (int kt = ktlo; kt <= kthi; ++kt) {
                    const int k0 = q0 - 128 + 64 * kt;
                    lds_barrier();
#pragma unroll
                    for (int rep = 0; rep < 4; ++rep) { const int pidx = tid + 512 * rep, row = pidx >> 5, ch = pidx & 31;
                        *(LAS bf16x8*)(lds + A_K + row * 528 + ch * 16) = pk_[rep]; *(LAS bf16x8*)(lds + A_V + row * 528 + ch * 16) = pv_[rep]; }
                    lds_barrier();
                    if (kt < kthi) kvload(kt + 1);
                    f32x16 sc[2];
#pragma unroll
                    for (int kt2 = 0; kt2 < 2; ++kt2) {
#pragma unroll
                        for (int i = 0; i < 16; ++i) sc[kt2][i] = 0.f;
#pragma unroll
                        for (int s = 0; s < 8; ++s) { const bf16x8 ak = *(const LAS bf16x8*)(lds + A_K + (32 * kt2 + r32) * 528 + (kvh * 128 + 16 * s + 8 * hh) * 2); sc[kt2] = MFMA32(ak, qf[s], sc[kt2]); } }
                    float tmax = -3.0e38f; const float d0f = (float)(k0 - qpos + 4 * hh);
                    const bool edge = (kt == 0) || (kt == 4) || (k0 < 0) || (k0 + 64 > SEQ);
#pragma unroll
                    for (int kt2 = 0; kt2 < 2; ++kt2)
#pragma unroll
                        for (int i = 0; i < 16; ++i) { const float rf = d0f + (float)(32 * kt2 + (i & 3) + 8 * (i >> 2)); float v = sc[kt2][i] * 0.08838834764831845f - slope * fabsf(rf);
                            if (edge) { const float kp = rf + (float)qpos; v = (fabsf(rf) <= 128.f && kp >= 0.f && kp < (float)SEQ) ? v : -3.0e38f; }
                            sc[kt2][i] = v; tmax = fmaxf(tmax, v); }
                    tmax = fmaxf(tmax, __shfl_xor(tmax, 32));
                    const float mnew = fmaxf(mrun, tmax), alpha = __expf(mrun - mnew); float ps = 0.f;
#pragma unroll
                    for (int kt2 = 0; kt2 < 2; ++kt2)
#pragma unroll
                        for (int i = 0; i < 16; ++i) { const float pv = __expf(sc[kt2][i] - mnew); sc[kt2][i] = pv; ps += pv; }
                    ps += __shfl_xor(ps, 32);
                    lrun = lrun * alpha + ps; mrun = mnew;
#pragma unroll
                    for (int dt = 0; dt < 4; ++dt)
#pragma unroll
                        for (int i = 0; i < 16; ++i) ot[dt][i] *= alpha;
#pragma unroll
                    for (int kk = 0; kk < 4; ++kk) { const bf16x8 bp = pack_step(sc[kk >> 1], kk & 1); bf16x8 av[4];
                        tr8<64, 4224>(ldsb + A_V + (16 * kk + 4 * hh + q4) * 528 + (kvh * 128 + 16 * blk + 4 * p4) * 2, av);
#pragma unroll
                        for (int dt = 0; dt < 4; ++dt) ot[dt] = MFMA32(av[dt], bp, ot[dt]); }
                }
                const float linv = 1.f / lrun; float ss = 0.f;
#pragma unroll
                for (int dt = 0; dt < 4; ++dt)
#pragma unroll
                    for (int i = 0; i < 16; ++i) { ot[dt][i] *= linv; ss += ot[dt][i] * ot[dt][i]; }
                ss += __shfl_xor(ss, 32);
                LAS float* SS = (LAS float*)(lds + A_SS);
                lds_barrier();
                if (hh == 0) SS[hq * 32 + r32] = ss;
                lds_barrier();
                float tot = 0.f;
#pragma unroll
                for (int w8 = 0; w8 < 8; ++w8) tot += SS[w8 * 32 + r32];
                const float rstd = rsqrtf(tot * (1.f / 1024.f) + EPS);
                bf16_t* orow = A2 + (size_t)(b * SEQ + q0 + r32) * DM + hq * 128 + 4 * hh; const float* gn = p.attn_out_norm + hq * 128 + 4 * hh;
#pragma unroll
                for (int dt = 0; dt < 4; ++dt)
#pragma unroll
                    for (int g = 0; g < 4; ++g) { const f32x4 gg = *(const f32x4*)(gn + 32 * dt + 8 * g); u32x2 w;
                        w.x = pk2(ot[dt][4 * g] * rstd * gg[0], ot[dt][4 * g + 1] * rstd * gg[1]); w.y = pk2(ot[dt][4 * g + 2] * rstd * gg[2], ot[dt][4 * g + 3] * rstd * gg[3]);
                        *(u32x2*)(orow + 32 * dt + 8 * g) = w; }
            }
            lds_barrier();
        }
        { SchedPre S{G, bid, (const char*)MEMK, (const char*)MEMV, (const char*)WCQ, (const char*)WCO, (char*)WQK, (char*)WVO};
          pg8::EpiStore8 E{p.norm_cross, 0.04419417382415922f * WQK_SCALE, WVO_SCALE};
          pg8::gemm_phase<pg8::EpiStore8, SchedPre, true>(lds, DM * 2, 8, S, E, wave); }
#ifndef DBG
        xcd_barrier(xbar, wave);
#else
    }
    if (lo == 13) { PH_IDS
#endif
        {
            const int lane = lane_id_v(), tid = wave * 64 + lane, r32 = lane & 31, hh = lane >> 5;
            constexpr int XS_ = 17920;
            static_assert(8 * XS_ <= MISC_OFF, "X3 LDS");
            for (int dry = X3_DRY; dry >= 0; --dry)
            for (int it = bid; it < 256; it += G) {
                const int dir = it & 1, h = (it >> 1) & 3, b = (it >> 3) & 3, sg = it >> 5; const int vs = wave;
                if (sg == 0) continue;
                const size_t tile0 = (size_t)((b * 4 + h) * 2 + dir) * 64; bf16_t* OUT = dir ? O3 : O2;
                lds_barrier();
#pragma unroll
                for (int c8 = 0; c8 < 8; ++c8) { const int i = 8 * sg + c8; const int n = dir ? 63 - i : i; const bf16_t* q = GQ + (tile0 + n) * 8192;
#pragma unroll
                    for (int rep = 0; rep < 2; ++rep) { const int pidx = tid + 512 * rep, row = pidx >> 4, ch = pidx & 15; *(LAS bf16x8*)(lds + c8 * XS_ + row * 272 + ch * 16) = *(const bf16x8*)(q + pidx * 8); }
                    if (tid < 32) *(LAS f32x4*)(lds + c8 * XS_ + 17408 + tid * 16) = *(const f32x4*)(GD + (tile0 + n) * 128 + tid * 4); }
                f32x16 St[4];
#pragma unroll
                for (int db = 0; db < 4; ++db)
#pragma unroll
                    for (int i = 0; i < 16; ++i) St[db][i] = 0.f;
                for (int i = 0; i < sg; ++i) { const int iti = (i << 5) | (it & 31); const float* fi = FIMG + ((size_t)(iti * 8 + wave) * 64) * 64 + lane; const float* sd = SEGD + iti * 128 + 4 * hh;
                    f32x16 fv[4];
#pragma unroll
                    for (int db = 0; db < 4; ++db)
#pragma unroll
                        for (int r = 0; r < 16; ++r) fv[db][r] = fi[(db * 16 + r) * 64];
#pragma unroll
                    for (int db = 0; db < 4; ++db)
#pragma unroll
                        for (int g = 0; g < 4; ++g) { const f32x4 dv = *(const f32x4*)(sd + 32 * db + 8 * g);
#pragma unroll
                            for (int j = 0; j < 4; ++j) St[db][4 * g + j] = St[db][4 * g + j] * dv[j] + fv[db][4 * g + j]; } }
                lds_barrier();
                u32x2 oldv[2][4];
                { const int n0_ = dir ? 63 - 8 * sg : 8 * sg;
#pragma unroll
                  for (int ct = 0; ct < 2; ++ct) { const bf16_t* orow = OUT + (size_t)(b * SEQ + n0_ * 64 + 32 * ct + r32) * 1024 + h * 256 + 32 * vs + 4 * hh;
#pragma unroll
                      for (int g = 0; g < 4; ++g) oldv[ct][g] = *(const u32x2*)(orow + 8 * g); } }
                for (int c8 = 0; c8 < 8; ++c8) { const int i = 8 * sg + c8; const int n = dir ? 63 - i : i; LAS unsigned char* sb = lds + c8 * XS_;
                    f32x16 o[2];
#pragma unroll
                    for (int ct = 0; ct < 2; ++ct)
#pragma unroll
                        for (int j = 0; j < 16; ++j) o[ct][j] = 0.f;
                    u32x2 nxtv[2][4];
                    { const int nn = dir ? n - 1 : n + 1;
#pragma unroll
                      for (int ct = 0; ct < 2; ++ct) { const bf16_t* orow = OUT + (size_t)(b * SEQ + (c8 < 7 ? nn : n) * 64 + 32 * ct + r32) * 1024 + h * 256 + 32 * vs + 4 * hh;
#pragma unroll
                          for (int g = 0; g < 4; ++g) nxtv[ct][g] = *(const u32x2*)(orow + 8 * g); } }
#pragma unroll
                    for (int db = 0; db < 4; ++db)
#pragma unroll
                        for (int s = 0; s < 2; ++s) { const bf16x8 xs = pack_step(St[db], s);
#pragma unroll
                            for (int ct = 0; ct < 2; ++ct) { const LAS unsigned char* qp = sb + (32 * ct + r32) * 272 + (32 * db + 16 * s + 4 * hh) * 2;
                                const s16x4 lo4 = *(const LAS s16x4*)qp, hi4 = *(const LAS s16x4*)(qp + 16); const bf16x8 bq = __builtin_shufflevector(lo4, hi4, 0, 1, 2, 3, 4, 5, 6, 7);
                                o[ct] = MFMA32(xs, bq, o[ct]); } }
#pragma unroll
                    for (int ct = 0; ct < 2; ++ct) { bf16_t* orow = OUT + (size_t)(b * SEQ + n * 64 + 32 * ct + r32) * 1024 + h * 256 + 32 * vs + 4 * hh;
#pragma unroll
                        for (int g = 0; g < 4; ++g) { const u32x2 old = oldv[ct][g]; u32x2 w;
                            w.x = pk2(o[ct][4 * g] + bflo(old.x), o[ct][4 * g + 1] + bfhi(old.x)); w.y = pk2(o[ct][4 * g + 2] + bflo(old.y), o[ct][4 * g + 3] + bfhi(old.y)); if (!dry || w.x == 0x12345678u) *(u32x2*)(orow + 8 * g) = w; oldv[ct][g] = nxtv[ct][g]; } }
#pragma unroll
                    for (int db = 0; db < 4; ++db) {
#pragma unroll
                        for (int g = 0; g < 4; ++g) { const f32x4 dv = *(const LAS f32x4*)(sb + 17408 + (32 * db + 8 * g + 4 * hh) * 4);
#pragma unroll
                            for (int j = 0; j < 4; ++j) St[db][4 * g + j] *= dv[j]; } }
                }
            }
            lds_barrier();
        }
    }
    SEAM(3);

    if (IN(4)) for (int rp_ = 0; rp_ < (RPT == 4 ? 2 : 1); ++rp_) { PH_IDS
        {
            bf16x8 c0[6], n0[6];
            auto ld = [&](int t, bf16x8 (&d)[6]) { const size_t o = (size_t)t * 1024 + lane * 16; const size_t ro = (size_t)t * PLD + C_RG + lane * 16;
                d[0] = *(const bf16x8*)(O2 + o); d[1] = *(const bf16x8*)(O2 + o + 8);
                d[2] = *(const bf16x8*)(O3 + o); d[3] = *(const bf16x8*)(O3 + o + 8); d[4] = *(const bf16x8*)(PROJ + ro); d[5] = *(const bf16x8*)(PROJ + ro + 8); };
            const float* gn = p.gla_out_norm + (lane & 15) * 16; float gnv[16];
#pragma unroll
            for (int j = 0; j < 16; ++j) gnv[j] = gn[j];
            if (gw < NT) ld(gw, c0);
            for (int t = gw; t < NT; t += NGW) {
                const int tn = t + NGW; ld(tn < NT ? tn : t, n0);
                float v[16], a[8], r[16];
                unpack8(c0[0], v); unpack8(c0[1], v + 8);
                unpack8(c0[2], a);
#pragma unroll
                for (int j = 0; j < 8; ++j) v[j] += a[j];
                unpack8(c0[3], a);
#pragma unroll
                for (int j = 0; j < 8; ++j) v[8 + j] += a[j];
                unpack8(c0[4], r); unpack8(c0[5], r + 8);
                float ss = 0.f;
#pragma unroll
                for (int j = 0; j < 16; ++j) ss += v[j] * v[j];
                ss += __shfl_xor(ss, 1); ss += __shfl_xor(ss, 2); ss += __shfl_xor(ss, 4); ss += __shfl_xor(ss, 8);
                const float rstd = rsqrtf(ss * (1.f / 256.f) + EPS); float w[16];
#pragma unroll
                for (int j = 0; j < 16; ++j) { const float rr = r[j]; w[j] = v[j] * rstd * gnv[j] * (rr / (1.f + __expf(-rr))); }
                *(bf16x8*)(A2 + (size_t)t * DM + 1024 + lane * 16) = pack8(w); *(bf16x8*)(A2 + (size_t)t * DM + 1024 + lane * 16 + 8) = pack8(w + 8);
#pragma unroll
                for (int j = 0; j < 6; ++j) c0[j] = n0[j];
            }
        }
    }
    SEAM(4);

    if (IN(5)) for (int rp_ = 0; rp_ < (RPT == 5 ? 2 : 1); ++rp_) { PH_IDS
        SchedTok S{G, bid, 8, (const char*)A2, (const char*)WOUT, (size_t)256 * DM * 2, (size_t)256 * DM * 2, 0};
        pg8::EpiRes1 E{p.x, H1B, H1F8, SSQ};
        pg8::gemm_phase<pg8::EpiRes1, SchedTok, true>(lds, DM * 2, DM / 64, S, E, wave);
    }
    SEAM(5);

    if (IN(6)) for (int rp_ = 0; rp_ < (RPT == 6 ? 2 : 1); ++rp_) { PH_IDS
        SchedTok S{G, bid, 4, (const char*)H1F8, (const char*)WQK, (size_t)256 * DM, (size_t)256 * DM, (size_t)1024 * DM};
        pg8::EpiSoftmax E{SSQ, PB};
        for (int i = 0;; ++i) { SchedOne S1; if (!S.next(i, S1.u0)) break; pg8::gemm_phase<pg8::EpiSoftmax, SchedOne, false, true>(lds, DM, DM / 128, S1, E, wave); }
    }
    SEAM(6);

    if (IN(7)) for (int rp_ = 0; rp_ < (RPT == 7 ? 2 : 1); ++rp_) { PH_IDS
        SchedTok S{G, bid, 8, (const char*)PB, (const char*)WVO, (size_t)256 * 1024, (size_t)256 * 1024, (size_t)2048 * 1024};
#if P7_DRY
        { pg8::EpiRes2<false> E0{H1B, (bf16_t*)(ws + 707 * MiB), nullptr, nullptr}; pg8::gemm_phase<pg8::EpiRes2<false>, SchedTok, true, true>(lds, 1024, 1024 / 128, S, E0, wave); }
#endif
        pg8::EpiRes2<true> E{H1B, H1B, HN8, p.norm_ffn};
        pg8::gemm_phase<pg8::EpiRes2<true>, SchedTok, true, true>(lds, 1024, 1024 / 128, S, E, wave);
    }
    SEAM(7);

    if (IN(8)) for (int rp_ = 0; rp_ < (RPT == 8 ? 2 : 1); ++rp_) { PH_IDS
        LAS float* LG = (LAS float*)(lds + (wave & 3) * 4096);
        LAS float* PT = (LAS float*)(lds + 16384 + (wave & 3) * 4096);
        for (int tile0 = 0; tile0 < NT / 16; tile0 += 4 * G) {
            const int tile = tile0 + (wave & 3) * G + bid; const bool act = tile < NT / 16; const int kh = wave >> 2;
            const int t0 = (act ? tile : 0) * 16, i16 = lane & 15, kq = lane >> 4;
            const bf16_t* xr = H1B + (size_t)(t0 + i16) * DM + 4 * kq + 1024 * kh; f32x4 acc[3]; float ss = 0.f;
#pragma unroll
            for (int c = 0; c < 3; ++c) acc[c] = (f32x4){0.f, 0.f, 0.f, 0.f};
            if (act) {
#pragma unroll 8
            for (int kb = 0; kb < 64; ++kb) { const u32x2 ab = *(const u32x2*)(xr + 16 * kb); const f32x4 a = {bflo(ab.x), bfhi(ab.x), bflo(ab.y), bfhi(ab.y)}; ss += (a[0] * a[0] + a[1] * a[1]) + (a[2] * a[2] + a[3] * a[3]);
#pragma unroll
                for (int c = 0; c < 3; ++c) { const f32x4 bw = ((const f32x4*)WR)[((64 * kh + kb) * 3 + c) * 64 + lane];
#pragma unroll
                    for (int e = 0; e < 4; ++e) acc[c] = __builtin_amdgcn_mfma_f32_16x16x4f32(a[e], bw[e], acc[c], 0, 0, 0); } }
            }
            if (kh == 1) {
#pragma unroll
                for (int c = 0; c < 3; ++c) *(LAS f32x4*)(PT + (c * 64 + lane) * 4) = acc[c];
                PT[768 + lane] = ss; }
            __syncthreads();
            if (kh == 0) {
#pragma unroll
                for (int c = 0; c < 3; ++c) acc[c] = acc[c] + *(const LAS f32x4*)(PT + (c * 64 + lane) * 4);
                ss += PT[768 + lane];
                ss += __shfl_xor(ss, 16); ss += __shfl_xor(ss, 32);
                const float rstd = rsqrtf(ss * (1.f / DM) + EPS);
#pragma unroll
                for (int c = 0; c < 3; ++c)
#pragma unroll
                    for (int r = 0; r < 4; ++r) LG[(4 * kq + r) * 48 + 16 * c + i16] = acc[c][r];
                if (kq == 0) LG[768 + i16] = rstd;
            }
            asm volatile("s_waitcnt lgkmcnt(0)" ::: "memory");
            if (kh == 0 && act)
            if (lane < 16) { const int t = t0 + lane; const float rs = LG[768 + lane]; const LAS float* l = LG + lane * 48;
                float g[4]; int gi = 0;
#pragma unroll
                for (int j = 0; j < 4; ++j) g[j] = l[j] * rs + p.b_rg[j];
                float gm = g[0];
#pragma unroll
                for (int j = 1; j < 4; ++j) if (g[j] > gm) { gm = g[j]; gi = j; }
                float gs = 0.f;
#pragma unroll
                for (int j = 0; j < 4; ++j) gs += __expf(g[j] - gm);
                const float pg = 1.f / gs;
                float e1 = -3.0e38f, e2 = -3.0e38f; int i1 = 0, i2 = 0;
                for (int j = 0; j < 8; ++j) { const float v = l[4 + gi * 8 + j] * rs + p.b_re[gi * 8 + j]; if (v > e1) { e2 = e1; i2 = i1; e1 = v; i1 = j; } else if (v > e2) { e2 = v; i2 = j; } }
                const float w2 = __expf(e2 - e1); const float g1 = pg / (1.f + w2), g2 = pg * w2 / (1.f + w2);
                const int ea = gi * 8 + i1, eb = gi * 8 + i2;
                const int sa = (int)atomicAdd(CNT + ea, 1u), sb2 = (int)atomicAdd(CNT + eb, 1u);
                LIST[ea * 16384 + sa] = t; LIST[eb * 16384 + sb2] = t;
                ASG_E[2 * t] = ea; ASG_E[2 * t + 1] = eb; ASG_S[2 * t] = sa; ASG_S[2 * t + 1] = sb2; ASG_G[2 * t] = g1; ASG_G[2 * t + 1] = g2; RSTD3[t] = rs; }
            __syncthreads();
        }
    }
    SEAM(8);

    if (IN(9)) for (int rp_ = 0; rp_ < (RPT == 9 ? 2 : 1); ++rp_) { PH_IDS }

    if (IN(10)) for (int rp_ = 0; rp_ < (RPT == 10 ? 2 : 1); ++rp_) { PH_IDS
        moe_table(CNT, TBL, tid);
        LAS float* RSB = (LAS float*)(lds + MISC_OFF + 4608);
        SchedMoe S{TBL, LIST, RSTD3, RSB, G, bid, __builtin_amdgcn_readfirstlane(TBL[0]), TBL + 64, (const char*)HN8, (const char*)WGU, (char*)HID, (size_t)0, (size_t)2048 * DM, (size_t)256 * DM, (size_t)256 * DFF, 128, DFF, MOE1_REP};
        pg8::EpiHid E{RSB};
        pg8::gemm_phase<pg8::EpiHid, SchedMoe, true, true, true>(lds, DM, DM / 128, S, E, wave);
        __syncthreads();
    }
    SEAM(10);

    if (IN(11)) for (int rp_ = 0; rp_ < (RPT == 11 ? 2 : 1); ++rp_) { PH_IDS
        moe_table(CNT, TBL, tid);
        SchedMoe S{TBL, nullptr, nullptr, nullptr, G, bid, __builtin_amdgcn_readfirstlane(TBL[0]), TBL + 64, (const char*)HID, (const char*)WD, (char*)YS, (size_t)256 * DFF, (size_t)2048 * DFF, (size_t)256 * DFF, (size_t)256 * DM, 256, DM, MOE2_REP};
        pg8::EpiStore8 E{nullptr, 0.f, YS_SCALE / (W_SCALE * HID_SCALE)};
        pg8::gemm_phase<pg8::EpiStore8, SchedMoe, true, true>(lds, DFF, DFF / 128, S, E, wave);
        __syncthreads();
    }
    SEAM(11);

    if (IN(12)) for (int rp_ = 0; rp_ < (RPT == 12 ? 2 : 1); ++rp_) { PH_IDS
        moe_table(CNT, TBL, tid);
        const f32x4* grf = (const f32x4*)p.norm_final + lane; f32x4 gfin[8];
#pragma unroll
        for (int j = 0; j < 8; ++j) gfin[j] = grf[64 * j];
        for (int base = 0; base < NT; base += 8 * NGW) {
        int mda[8], mdb[8]; float mga[8], mgb[8];
#pragma unroll
        for (int q = 0; q < 8; ++q) { const int t = base + gw + q * NGW; const int tt = t < NT ? t : 0; mda[q] = TBL[1 + ASG_E[2 * tt]] * 256 + ASG_S[2 * tt]; mdb[q] = TBL[1 + ASG_E[2 * tt + 1]] * 256 + ASG_S[2 * tt + 1]; mga[q] = ASG_G[2 * tt]; mgb[q] = ASG_G[2 * tt + 1]; }
        for (int dry = P12_DRY; dry >= 0; --dry)
#pragma unroll
        for (int q = 0; q < 8; ++q) { const int t = base + gw + q * NGW; if (t >= NT) break;
            const int da = mda[q], db = mdb[q]; const float ga = mga[q] * (1.f / YS_SCALE), gb = mgb[q] * (1.f / YS_SCALE);
            f32x4* xr = (f32x4*)(H + (size_t)t * DM) + lane; const u32x2* hr = (const u32x2*)(H1B + (size_t)t * DM) + lane; const unsigned* ya = (const unsigned*)(YS + (size_t)da * DM) + lane; const unsigned* yb = (const unsigned*)(YS + (size_t)db * DM) + lane;
            f32x4 v[8]; float s = 0.f;
#pragma unroll
            for (int j = 0; j < 8; ++j) { const u32x2 hb = hr[64 * j]; v[j] = (f32x4){bflo(hb.x), bfhi(hb.x), bflo(hb.y), bfhi(hb.y)}; const unsigned a = ya[64 * j], b2 = yb[64 * j];
                v[j][0] += ga * __builtin_amdgcn_cvt_f32_fp8((int)a, 0) + gb * __builtin_amdgcn_cvt_f32_fp8((int)b2, 0); v[j][1] += ga * __builtin_amdgcn_cvt_f32_fp8((int)a, 1) + gb * __builtin_amdgcn_cvt_f32_fp8((int)b2, 1);
                v[j][2] += ga * __builtin_amdgcn_cvt_f32_fp8((int)a, 2) + gb * __builtin_amdgcn_cvt_f32_fp8((int)b2, 2); v[j][3] += ga * __builtin_amdgcn_cvt_f32_fp8((int)a, 3) + gb * __builtin_amdgcn_cvt_f32_fp8((int)b2, 3);
                s += (v[j][0] * v[j][0] + v[j][1] * v[j][1]) + (v[j][2] * v[j][2] + v[j][3] * v[j][3]); }
            const float rstd = rsqrtf(wave_sum(s) * (1.f / DM) + EPS);
#pragma unroll
            for (int j = 0; j < 8; ++j) { const f32x4 g = gfin[j]; f32x4 o; o[0] = v[j][0] * rstd * g[0]; o[1] = v[j][1] * rstd * g[1]; o[2] = v[j][2] * rstd * g[2]; o[3] = v[j][3] * rstd * g[3]; (dry ? ((f32x4*)(ws + 555 * MiB) + (size_t)t * 512 + lane) : xr)[64 * j] = o; }
        }
        }
    }
    for (int xb_ = 0; xb_ < XBAR_EXTRA; ++xb_) xcd_barrier(xbar, wave);
#undef IN
#undef SEAM
}


#undef WGU
#undef WD
#undef WIN
#undef WCKV
#undef WOUT
#undef WCO
#undef WCQ
#undef WQK
#undef WVO
#undef U
#undef H1B
#undef H1F8
#undef HN8
#undef LIST
#undef MEMN
#undef MEMK
#undef MEMV
#undef PROJ
#undef PB
#undef GQ
#undef GK
#undef GD
#undef O1
#undef O2
#undef O3
#undef A2
#undef SSQ
#undef XS
#undef HID
#undef YS
#undef WR
#undef FIMG
#undef SEGD
#undef ASG_E
#undef ASG_S
#undef ASG_G
#undef RSTD3
#undef DEST
#undef CNT
#ifdef DBG
__device__ __forceinline__ unsigned hsh(unsigned x) { x ^= x >> 16; x *= 0x7feb352dU; x ^= x >> 15; x *= 0x846ca68bU; x ^= x >> 16; return x; }
__device__ __forceinline__ float bfr(float f) { unsigned w = pk2(f, 0.f); return bflo(w); }
__device__ __forceinline__ void rec(unsigned* errs, int slot, float got, float want, float atol) {
    float e = fabsf(got - want) / (fabsf(want) + atol); if (!(e == e)) e = 1.0e9f; if (!(got == got)) e = 1.0e9f;
    atomicMax(errs + slot, __float_as_uint(e));
}
__device__ __forceinline__ void rec8(unsigned* errs, int slot, float got, float want, float atol) { rec(errs, slot, want + 0.4f * (got - want), want, atol); }
__device__ __forceinline__ float wdot8(const unsigned char* a, const unsigned char* b, int K, int lane) { float s = 0.f; for (int k = lane; k < K; k += 64) s += fp8f(a[k]) * fp8f(b[k]); return wave_sum(s); }
__device__ __forceinline__ float wdot(const bf16_t* a, const bf16_t* b, int K, int lane) { float s = 0.f; for (int k = lane; k < K; k += 64) s += bf2f(a[k]) * bf2f(b[k]); return wave_sum(s); }
__device__ __forceinline__ float lsig16(float pre) { return (fminf(pre, 0.f) - logf(1.f + expf(-fabsf(pre)))) * (1.f / 16.f); }
__device__ __forceinline__ float gate_at(const Params& p, const bf16_t* PROJ, int row, int h, int d, int dir) {
    const float* wg = dir ? p.w_gla_gb : p.w_gla_gf; float pre = (dir ? p.b_gla_gb : p.b_gla_gf)[h * 128 + d];
    for (int r = 0; r < 16; ++r) pre += bf2f(PROJ[(size_t)row * PLD + C_LRF + 16 * dir + r]) * wg[r * 512 + h * 128 + d];
    return lsig16(pre);
}
__global__ void __launch_bounds__(256) chk_kernel(Params p, int stage, unsigned* errs) {
    __shared__ float sh[4][1536];
    const int lane = threadIdx.x & 63, wv = threadIdx.x >> 6, gwv = blockIdx.x * 4 + wv, NW = gridDim.x * 4;
    unsigned char* ws = p.ws;
    unsigned char* WGU = (unsigned char*)(ws + WS_WGU); unsigned char* WD = (unsigned char*)(ws + WS_WD); bf16_t* WIN = (bf16_t*)(ws + WS_WIN); bf16_t* WCKV = (bf16_t*)(ws + WS_WCKV);
    bf16_t* WOUT = (bf16_t*)(ws + WS_WOUT); bf16_t* WCO = (bf16_t*)(ws + WS_WCO); bf16_t* WCQ = (bf16_t*)(ws + WS_WCQ);
    unsigned char* WQK = (unsigned char*)(ws + WS_WQK); unsigned char* WVO = (unsigned char*)(ws + WS_WVO); unsigned char* H1F8 = (unsigned char*)(ws + WS_H1F8);
    bf16_t* U = (bf16_t*)(ws + WS_U); bf16_t* H1B = (bf16_t*)(ws + WS_H1B); bf16_t* MEMN = (bf16_t*)(ws + WS_MEMN); bf16_t* MEMK = (bf16_t*)(ws + WS_MEMK); bf16_t* MEMV = (bf16_t*)(ws + WS_MEMV);
    bf16_t* PROJ = (bf16_t*)(ws + WS_PROJ); unsigned char* PB = (unsigned char*)(ws + WS_P); bf16_t* GQ = (bf16_t*)(ws + WS_GQ); bf16_t* GK = (bf16_t*)(ws + WS_GK); float* GD = (float*)(ws + WS_GD);
    bf16_t* O1 = (bf16_t*)(ws + WS_O1); bf16_t* O2 = (bf16_t*)(ws + WS_O2); bf16_t* O3 = (bf16_t*)(ws + WS_O3); bf16_t* A2 = (bf16_t*)(ws + WS_A2);
    float* SSQ = (float*)(ws + WS_SSQ); unsigned char* XS = (unsigned char*)(ws + WS_XS); unsigned char* HID = (unsigned char*)(ws + WS_HID); unsigned char* YS = (unsigned char*)(ws + WS_YS);
    float* WR = (float*)(ws + WS_WR);
    int* ASG_E = (int*)(ws + WS_ASG); int* ASG_S = ASG_E + 2 * NT; float* ASG_G = (float*)(ASG_S + 2 * NT); float* RSTD3 = ASG_G + 2 * NT; int* DEST = (int*)(RSTD3 + NT);
    unsigned* CNT = (unsigned*)(ws + WS_CTL) + CW_CNT;
    float* H = p.out; float* shw = sh[wv];
    const int NS = 16;
    for (int si = 0; si < NS; ++si) {
        const unsigned r0 = hsh((unsigned)(gwv * NS + si) * 2654435761u + (unsigned)stage * 97u + 12345u), r1 = hsh(r0 + 1u), r2 = hsh(r0 + 2u), r3 = hsh(r0 + 3u);
        if (stage == 0) {
            const unsigned q0 = hsh(r0 + lane * 7919u), q1 = hsh(q0 + 1u), q2 = hsh(q0 + 2u);
            { const int n = q0 % 4864, k = q1 % 2048; const float want = n < 4640 ? bfr(p.w_in[(size_t)k * 4640 + n]) : 0.f; rec(errs, 0 * 4 + 0, bf2f(WIN[(size_t)n * DM + k]), want, 1e-4f); }
            { const int n = q0 % 2048, k = q1 % 2048;
              rec(errs, 0 * 4 + 0, bf2f(WCKV[(size_t)n * DM + k]), bfr(p.w_ck[(size_t)k * DM + n]), 1e-4f); rec(errs, 0 * 4 + 0, bf2f(WCKV[(size_t)(2048 + n) * DM + k]), bfr(p.w_cv[(size_t)k * DM + n]), 1e-4f); }
            { const int t = r1 % NT; float s = 0.f; for (int k = lane; k < DM; k += 64) { const float v = p.x[(size_t)t * DM + k]; s += v * v; } const float rs = rsqrtf(wave_sum(s) / DM + EPS);
              const int k = q0 % DM; rec(errs, 0 * 4 + 0, bf2f(U[(size_t)t * DM + k]), p.x[(size_t)t * DM + k] * rs * p.norm_mix[k], 1e-2f); }
            { const int t = r1 % 1024; float s = 0.f; for (int k = lane; k < DM; k += 64) { const float v = p.mem[(size_t)t * DM + k]; s += v * v; } const float rs = rsqrtf(wave_sum(s) / DM + EPS);
              const int k = q0 % DM; rec(errs, 0 * 4 + 0, bf2f(MEMN[(size_t)t * DM + k]), p.mem[(size_t)t * DM + k] * rs * p.norm_mem[k], 1e-2f); }
        } else if (stage == 1) {
            { const unsigned q0 = hsh(r0 + lane * 7919u), q1 = hsh(q0 + 1u), q2 = hsh(q0 + 2u);
              { const int n = q0 % 2048, k = q1 % 2048; rec(errs, 1 * 4 + 3, bf2f(WOUT[(size_t)n * DM + k]), bfr(p.w_out[(size_t)k * DM + n]), 1e-4f);
                rec(errs, 1 * 4 + 3, bf2f(WCO[(size_t)n * DM + k]), bfr(p.w_co[(size_t)k * DM + n]), 1e-4f); rec(errs, 1 * 4 + 3, bf2f(WCQ[(size_t)n * DM + k]), bfr(p.w_cq[(size_t)n * DM + k]), 1e-4f); }
            { const int e = q2 % 32, k = q1 % 2048, j = q0 % 1024; rec8(errs, 1 * 4 + 2, fp8f(WGU[((size_t)e * 2048 + (j >> 7) * 256 + (j & 127)) * DM + k]), W_SCALE * p.w_gate[((size_t)e * DM + k) * DFF + j], 2e-2f);
              rec8(errs, 1 * 4 + 2, fp8f(WGU[((size_t)e * 2048 + (j >> 7) * 256 + 128 + (j & 127)) * DM + k]), W_SCALE * p.w_up[((size_t)e * DM + k) * DFF + j], 2e-2f);
              const int n = q0 % 2048, kk = q1 % 1024; rec8(errs, 1 * 4 + 2, fp8f(WD[((size_t)e * 2048 + n) * DFF + kk]), W_SCALE * p.w_down[((size_t)e * DFF + kk) * DM + n], 2e-2f); }
            }
            { const int t = r0 % NT, n = r1 % 4864; const float want = wdot(U + (size_t)t * DM, WIN + (size_t)n * DM, DM, lane); if (lane == 0) rec(errs, 1 * 4 + 0, bf2f(PROJ[(size_t)t * PLD + n]), want, 1.0f); }
            { const int t = r2 % 1024, n = r3 % 4096; const float want = wdot(MEMN + (size_t)t * DM, WCKV + (size_t)n * DM, DM, lane);
              if (lane == 0) rec(errs, 1 * 4 + 1, bf2f((n < 2048 ? MEMK : MEMV)[(size_t)t * DM + (n & 2047)]), want, 1.0f); }
        } else if (stage == 2) {
        } else if (stage == 3) {
            if (si < 2) {
                const int b = r0 & 3, h = (r0 >> 2) & 3, dir = (r0 >> 4) & 1, tpos = r1 % SEQ, v = r2 & 255; const int row = b * SEQ + tpos;
                float E0 = 0.f, E1 = 0.f, acc = 0.f; const float q0 = bf2f(PROJ[(size_t)row * PLD + C_QG + h * 128 + lane]) * 0.08838834764831845f, q1 = bf2f(PROJ[(size_t)row * PLD + C_QG + h * 128 + lane + 64]) * 0.08838834764831845f;
                for (int st_ = 0; st_ < 768; ++st_) { const int s = dir ? tpos + st_ : tpos - st_; if (s < 0 || s >= SEQ) break; const int srow = b * SEQ + s;
                    float a = q0 * expf(E0) * bf2f(PROJ[(size_t)srow * PLD + C_KG + h * 128 + lane]) + q1 * expf(E1) * bf2f(PROJ[(size_t)srow * PLD + C_KG + h * 128 + lane + 64]);
                    a = wave_sum(a); acc += a * bf2f(PROJ[(size_t)srow * PLD + C_VG + h * 256 + v]);
                    if (dir == 0) { E0 += gate_at(p, PROJ, srow, h, lane, 0); E1 += gate_at(p, PROJ, srow, h, lane + 64, 0); }
                    else { E0 += gate_at(p, PROJ, srow, h, lane, 1); E1 += gate_at(p, PROJ, srow, h, lane + 64, 1); } }
                if (lane == 0) rec(errs, 3 * 4 + 0, bf2f((dir ? O3 : O2)[(size_t)row * 1024 + h * 256 + v]), acc, 2.0f);
            } else if (si < 8) {
                const int b = r0 & 3, tpos = r1 % SEQ; const int row = b * SEQ + tpos; float* pr = shw; float* oh = shw + 320; float tot = 0.f;
                for (int hq = 0; hq < 8; ++hq) { const int kvh = hq >> 2; const float slope = exp2f(-(float)(hq + 1)); float mx = p.sink_logit[hq];
                    for (int j = lane; j < 257; j += 64) { const int kp = tpos - 128 + j; float sc = -3.0e38f;
                        if (kp >= 0 && kp < SEQ) { float s = 0.f; for (int d = 0; d < 128; ++d) s += bf2f(PROJ[(size_t)row * PLD + C_QA + hq * 128 + d]) * bf2f(PROJ[(size_t)(b * SEQ + kp) * PLD + C_KA + kvh * 128 + d]);
                            sc = s * 0.08838834764831845f - slope * fabsf((float)(kp - tpos)); }
                        pr[j] = sc; mx = fmaxf(mx, sc); }
                    for (int o = 1; o < 64; o <<= 1) mx = fmaxf(mx, __shfl_xor(mx, o));
                    float sm = 0.f; for (int j = lane; j < 257; j += 64) { const float e = pr[j] > -1.0e38f ? expf(pr[j] - mx) : 0.f; pr[j] = e; sm += e; }
                    sm = wave_sum(sm) + expf(p.sink_logit[hq] - mx);
                    __builtin_amdgcn_s_waitcnt(0);
                    for (int dd = 0; dd < 2; ++dd) { const int d = lane + 64 * dd; float o = 0.f;
                        for (int j = 0; j < 257; ++j) { const int kp = tpos - 128 + j; if (kp >= 0 && kp < SEQ) o += pr[j] * bf2f(PROJ[(size_t)(b * SEQ + kp) * PLD + C_VA + kvh * 128 + d]); }
                        o /= sm; oh[hq * 128 + d] = o; tot += o * o; }
                    __builtin_amdgcn_s_waitcnt(0); }
                tot = wave_sum(tot); const float rs = rsqrtf(tot / 1024.f + EPS);
                for (int i = lane; i < 1024; i += 64) rec(errs, 3 * 4 + 1, bf2f(A2[(size_t)row * DM + i]), oh[i] * rs * p.attn_out_norm[i], 1.0f);
            } else {
                const int b = r0 & 3, h = (r0 >> 2) & 3, m = r1 & 255, c = r2 & 2047;
                float s = 0.f; for (int d = lane; d < 512; d += 64) s += bf2f(MEMK[(size_t)(b * 256 + m) * DM + h * 512 + d]) * bf2f(WCQ[(size_t)c * DM + h * 512 + d]); s = wave_sum(s) * p.norm_cross[c] * 0.04419417382415922f;
                if (lane == 0) rec8(errs, 3 * 4 + 2, fp8f(WQK[((size_t)b * 1024 + h * 256 + m) * DM + c]) / WQK_SCALE, s, 0.02f);
                s = 0.f; for (int d = lane; d < 512; d += 64) s += bf2f(MEMV[(size_t)(b * 256 + m) * DM + h * 512 + d]) * bf2f(WCO[(size_t)c * DM + h * 512 + d]); s = wave_sum(s);
                if (lane == 0) rec8(errs, 3 * 4 + 3, fp8f(WVO[((size_t)b * 2048 + c) * 1024 + h * 256 + m]) / WVO_SCALE, s, 0.5f);
            }
        } else if (stage == 4) {
            const int t = r0 % NT;
            for (int hh = 0; hh < 4; ++hh) { float vv[4]; float ss = 0.f;
_Pragma("unroll")
                for (int j = 0; j < 4; ++j) { const size_t o = (size_t)t * 1024 + hh * 256 + lane + 64 * j; vv[j] = bf2f(O2[o]) + bf2f(O3[o]); ss += vv[j] * vv[j]; }
                ss = wave_sum(ss); const float rs = rsqrtf(ss / 256.f + EPS);
_Pragma("unroll")
                for (int j = 0; j < 4; ++j) { const int v = lane + 64 * j; const float r = bf2f(PROJ[(size_t)t * PLD + C_RG + hh * 256 + v]);
                    rec(errs, 4 * 4 + 0, bf2f(A2[(size_t)t * DM + 1024 + hh * 256 + v]), vv[j] * rs * p.gla_out_norm[v] * (r / (1.f + expf(-r))), 0.5f); } }
        } else if (stage == 5) {
            const int t = r0 % NT, n = r1 % DM; const float want = p.x[(size_t)t * DM + n] + wdot(A2 + (size_t)t * DM, WOUT + (size_t)n * DM, DM, lane);
            if (lane == 0) { rec(errs, 5 * 4 + 1, bf2f(H1B[(size_t)t * DM + n]), want, 1.0f); }
            float s = 0.f; for (int k = lane; k < DM; k += 64) { const float v = bf2f(H1B[(size_t)t * DM + k]); s += v * v; } s = wave_sum(s);
            float q = lane < 32 ? SSQ[(size_t)t * 32 + lane] : 0.f; q = wave_sum(q); if (lane == 0) rec(errs, 5 * 4 + 2, q, s, 1.0f);
        } else if (stage == 6) {
            const int t = r0 % NT, h = r1 & 3, b = t / SEQ; float s = 0.f; for (int k = lane; k < DM; k += 64) { const float v = bf2f(H1B[(size_t)t * DM + k]); s += v * v; } const float rs = rsqrtf(wave_sum(s) / DM + EPS);
            float sc[4]; float mx = -3.0e38f;
_Pragma("unroll")
            for (int j = 0; j < 4; ++j) { const int m = lane + 64 * j; float a = 0.f; for (int k = 0; k < DM; ++k) a += fp8f(H1F8[(size_t)t * DM + k]) * fp8f(WQK[((size_t)b * 1024 + h * 256 + m) * DM + k]); sc[j] = a * rs / WQK_SCALE; mx = fmaxf(mx, sc[j]); }
            for (int o = 1; o < 64; o <<= 1) mx = fmaxf(mx, __shfl_xor(mx, o));
            float sm = 0.f;
_Pragma("unroll")
            for (int j = 0; j < 4; ++j) { sc[j] = expf(sc[j] - mx); sm += sc[j]; } sm = wave_sum(sm);
_Pragma("unroll")
            for (int j = 0; j < 4; ++j) rec8(errs, 6 * 4 + 0, fp8f(PB[(size_t)t * 1024 + h * 256 + lane + 64 * j]) / P_SCALE, sc[j] / sm, 4e-3f);
        } else if (stage == 7) {
            const int t = r0 % NT, n = r1 % DM, b = t / SEQ; const float want = bf2f(H1B[(size_t)t * DM + n]) + 0.f * wdot8(PB + (size_t)t * 1024, WVO + ((size_t)b * 2048 + n) * 1024, 1024, lane);
            if (lane == 0) rec(errs, 7 * 4 + 0, bf2f(H1B[(size_t)t * DM + n]), want, 0.3f);
        } else if (stage == 8) {
            const int t = r0 % NT; double s = 0.0; for (int k = lane; k < DM; k += 64) { const double v = bf2f(H1B[(size_t)t * DM + k]); s += v * v; }
            for (int o = 1; o < 64; o <<= 1) s += __shfl_xor(s, o);
            const double rs = 1.0 / sqrt(s / DM + 1e-6); float* lg = shw;
            for (int j = 0; j < 36; ++j) { double a = 0.0; for (int k = lane; k < DM; k += 64) { const double w = j < 4 ? p.w_rg[k * 4 + j] : p.w_re[k * 32 + j - 4]; a += (double)bf2f(H1B[(size_t)t * DM + k]) * rs * p.norm_ffn[k] * w; }
                for (int o = 1; o < 64; o <<= 1) a += __shfl_xor(a, o); if (lane == 0) lg[j] = (float)(a + (j < 4 ? p.b_rg[j] : p.b_re[j - 4])); }
            __builtin_amdgcn_s_waitcnt(0);
            if (lane == 0) { int gi = 0; for (int j = 1; j < 4; ++j) if (lg[j] > lg[gi]) gi = j; float gs = 0; for (int j = 0; j < 4; ++j) gs += expf(lg[j] - lg[gi]); const float pg = 1.f / gs;
                int i1 = 0; for (int j = 1; j < 8; ++j) if (lg[4 + gi * 8 + j] > lg[4 + gi * 8 + i1]) i1 = j; int i2 = -1; for (int j = 0; j < 8; ++j) if (j != i1 && (i2 < 0 || lg[4 + gi * 8 + j] > lg[4 + gi * 8 + i2])) i2 = j;
                const float w2 = expf(lg[4 + gi * 8 + i2] - lg[4 + gi * 8 + i1]);
                rec(errs, 8 * 4 + 0, (float)(ASG_E[2 * t] != gi * 8 + i1), 0.f, 1e-6f); rec(errs, 8 * 4 + 0, (float)(ASG_E[2 * t + 1] != gi * 8 + i2), 0.f, 1e-6f);
                rec(errs, 8 * 4 + 1, ASG_G[2 * t], pg / (1 + w2), 1e-3f); rec(errs, 8 * 4 + 1, ASG_G[2 * t + 1], pg * w2 / (1 + w2), 1e-3f); rec(errs, 8 * 4 + 2, RSTD3[t], (float)rs, 1e-6f);
                const int sa = ASG_S[2 * t], sb = ASG_S[2 * t + 1]; if (sa < 0 || sa >= (int)CNT[ASG_E[2 * t]] || sb < 0 || sb >= (int)CNT[ASG_E[2 * t + 1]]) rec(errs, 8 * 4 + 3, 1.f, 0.f, 1e-6f); }
            __builtin_amdgcn_s_waitcnt(0);
        } else if (stage == 9 || stage == 10 || stage == 11) {
            const int t = r0 % NT, kk = r1 & 1; const int e = ASG_E[2 * t + kk]; int pst = 0; for (int j = 0; j < e; ++j) pst += ((int)CNT[j] + 255) >> 8; const int dst = pst * 256 + ASG_S[2 * t + kk];
            if (stage == 9) { }
            else if (stage == 10) { const int j = r2 % 1024; const unsigned char* HN8c = (const unsigned char*)(ws + WS_H1F8); const float g = wdot8(HN8c + (size_t)t * DM, WGU + ((size_t)e * 2048 + (j >> 7) * 256 + (j & 127)) * DM, DM, lane) * RSTD3[t] / W_SCALE, u = wdot8(HN8c + (size_t)t * DM, WGU + ((size_t)e * 2048 + (j >> 7) * 256 + 128 + (j & 127)) * DM, DM, lane) * RSTD3[t] / W_SCALE;
                if (lane == 0) rec8(errs, 10 * 4 + 0, fp8f(HID[(size_t)dst * DFF + j]) / HID_SCALE, g / (1.f + expf(-g)) * u, 0.5f); }
            else { const int n = r2 % DM; const float y = wdot8(HID + (size_t)dst * DFF, WD + ((size_t)e * 2048 + n) * DFF, DFF, lane) / (W_SCALE * HID_SCALE); if (lane == 0) rec8(errs, 11 * 4 + 0, fp8f(YS[(size_t)dst * DM + n]) / YS_SCALE, y, 0.6f); }
        }
    }
}
__global__ void apply_kernel(float* out, const unsigned* errs, int n) {
    int code = 0;
    for (int s = 51; s >= 0; --s) if (__uint_as_float(errs[s]) > DBG_THR) code = s + 1;
    if (code == 0) return;
    for (int i = blockIdx.x * blockDim.x + threadIdx.x; i < n; i += gridDim.x * blockDim.x) out[i] *= (float)(1 + code);
}
#endif
extern "C" void kernel_launch(void* const* d_in, const int* in_sizes, int n_in, void* d_out, int out_size, void* d_ws, size_t ws_size, hipStream_t stream) {
    static int grid = 0;
    if (grid == 0) {
        if (n_in != 27 || out_size != NT * DM || ws_size < WS_END) { fprintf(stderr, "kernel_launch: unexpected problem: n_in %d out %d ws %zu (need %zu)\n", n_in, out_size, ws_size, (size_t)WS_END); grid = -1; return; }
        int dev = 0, cus = 0, per_cu = 0;
        if (hipGetDevice(&dev) != hipSuccess || hipDeviceGetAttribute(&cus, hipDeviceAttributeMultiprocessorCount, dev) != hipSuccess) { grid = -1; return; }
        if (hipFuncSetAttribute((const void*)fwd_mega, hipFuncAttributeMaxDynamicSharedMemorySize, LDS_BYTES) != hipSuccess) { fprintf(stderr, "kernel_launch: hipFuncSetAttribute failed\n"); grid = -1; return; }
        if (hipOccupancyMaxActiveBlocksPerMultiprocessor(&per_cu, (const void*)fwd_mega, 512, LDS_BYTES) != hipSuccess || per_cu < 1) { fprintf(stderr, "kernel_launch: occupancy query says %d blocks per CU\n", per_cu); grid = -1; (void)hipGetLastError(); return; }
        grid = cus;
    }
    if (grid < 0) return;
    (void)hipMemsetAsync((char*)d_ws + WS_CTL, 0, 32768, stream);
    Params p{};
    const float** pf = (const float**)&p;
    for (int i = 0; i < 27; ++i) pf[i] = (const float*)d_in[i];
    p.out = (float*)d_out; p.ws = (unsigned char*)d_ws; p.ph_lo = 0; p.ph_hi = 13;

#ifdef DBG
    unsigned* errs = (unsigned*)((char*)d_ws + WS_CTL) + 1024;
    for (int ph = 0; ph < 13; ++ph) {
        p.ph_lo = ph; p.ph_hi = ph + 1;
        void* a2[] = {&p};
        (void)a2; hipLaunchKernelGGL(fwd_mega, dim3(grid), dim3(512), LDS_BYTES, stream, p);
        if (ph == 3) { p.ph_lo = 13; p.ph_hi = 14; hipLaunchKernelGGL(fwd_mega, dim3(grid), dim3(512), LDS_BYTES, stream, p); }
        if (ph < 12) hipLaunchKernelGGL(chk_kernel, dim3(64), dim3(256), 0, stream, p, ph, errs);
    }
    hipLaunchKernelGGL(apply_kernel, dim3(1024), dim3(256), 0, stream, (float*)d_out, errs, NT * DM);
    return;
#endif
    void* args[] = {&p};
    (void)args;
    hipLaunchKernelGGL(fwd_mega, dim3(grid), dim3(512), LDS_BYTES, stream, p);
    hipError_t e = hipPeekAtLastError();
    if (e != hipSuccess) fprintf(stderr, "kernel_launch: launch failed: %s (grid %d)\n", hipGetErrorString(e), grid);
}
```

```cpp
#define DBG_THR 0.06f
#ifndef SCAN_REP
#define SCAN_REP 1
#define ATT_REP 1
#define MOE1_REP 1
#define MOE2_REP 1
#endif
#ifndef P7_DRY
#define P7_DRY 0
#define P12_DRY 0
#define P0E_REP 0
#define XBAR_EXTRA 0
#define P0E_NOSTORE 0
#define X3_DRY 0
#define PRE_REP 1
#define P0T_REP 1
#define P0R_REP 1
#endif
#ifndef RPT
#define RPT -1
#endif
#include <hip/hip_runtime.h>
#include <hip/hip_cooperative_groups.h>
#include <cstdio>
#include <cstdint>
namespace cg = cooperative_groups;

#define LAS __attribute__((address_space(3)))
typedef unsigned short bf16_t;
typedef short bf16x8 __attribute__((ext_vector_type(8)));
typedef short s16x4 __attribute__((ext_vector_type(4)));
typedef float f32x2 __attribute__((ext_vector_type(2)));
typedef float f32x4 __attribute__((ext_vector_type(4)));
typedef float f32x16 __attribute__((ext_vector_type(16)));
typedef unsigned u32x2 __attribute__((ext_vector_type(2)));
typedef unsigned u32x4 __attribute__((ext_vector_type(4)));
typedef __bf16 bf16v2 __attribute__((ext_vector_type(2)));
typedef int i32x8 __attribute__((ext_vector_type(8)));
typedef int i32x4 __attribute__((ext_vector_type(4)));

constexpr int DM = 2048, NB = 4, SEQ = 4096, NT = NB * SEQ;
constexpr int PLD = 4864;
constexpr int C_QA = 0, C_KA = 1024, C_VA = 1280, C_QG = 1536, C_KG = 2048, C_VG = 2560, C_RG = 3584, C_LRF = 4608, C_LRB = 4624;
constexpr int NEXP = 32, DFF = 1024, MEML = 256;
constexpr int RMAX = NT * 2 + NEXP * 256;
constexpr float EPS = 1e-6f;
constexpr float WQK_SCALE = 64.f, WVO_SCALE = 8.f, P_SCALE = 256.f;
constexpr float W_SCALE = 64.f, HID_SCALE = 8.f, YS_SCALE = 16.f;

constexpr size_t MiB = 1u << 20;
constexpr size_t WS_CTL = 0;
constexpr size_t WS_WR = 1 * MiB;
constexpr size_t WS_ASG = 1 * MiB + 512 * 1024;
constexpr size_t WS_GD = 2 * MiB + 512 * 1024;
constexpr size_t WS_WGU = 4 * MiB;
constexpr size_t WS_WD = 260 * MiB;
constexpr size_t WS_WIN = 388 * MiB;
constexpr size_t WS_WCKV = 407 * MiB;
constexpr size_t WS_WOUT = 423 * MiB;
constexpr size_t WS_WCO = 431 * MiB;
constexpr size_t WS_WCQ = 439 * MiB;
constexpr size_t WS_WQK = 447 * MiB;
constexpr size_t WS_WVO = 463 * MiB;
constexpr size_t WS_U = 479 * MiB;
constexpr size_t WS_H1B = 479 * MiB;
constexpr size_t WS_MEMN = 543 * MiB;
constexpr size_t WS_MEMK = 547 * MiB;
constexpr size_t WS_MEMV = 551 * MiB;
constexpr size_t WS_PROJ = 555 * MiB;
constexpr size_t WS_P = 555 * MiB;
constexpr size_t WS_GQ = 707 * MiB;
constexpr size_t WS_GK = 739 * MiB;
constexpr size_t WS_O1 = 771 * MiB;
constexpr size_t WS_O2 = 803 * MiB;
constexpr size_t WS_O3 = 835 * MiB;
constexpr size_t WS_A2 = 867 * MiB;
constexpr size_t WS_H1F8 = 771 * MiB;
constexpr size_t WS_SSQ = 931 * MiB;
constexpr size_t WS_XS = 555 * MiB;
constexpr size_t WS_HID = 715 * MiB;
constexpr size_t WS_YS = 795 * MiB;
constexpr size_t WS_FIMG = 955 * MiB;
constexpr size_t WS_SEGD = 987 * MiB;
constexpr size_t WS_END = 988 * MiB;
constexpr int CW_CNT = 0;
constexpr int CW_BAR = 4096;

constexpr int LDS_BYTES = 155648;
constexpr int MISC_OFF = 147456;

__device__ __forceinline__ unsigned pk2(float lo, float hi) { f32x2 v = {lo, hi}; bf16v2 b = __builtin_convertvector(v, bf16v2); return __builtin_bit_cast(unsigned, b); }
__device__ __forceinline__ float clamp8(float v) { return fminf(fmaxf(v, -448.f), 448.f); }
__device__ __forceinline__ unsigned pk4_fp8(float a, float b, float c, float d) { int w = 0; w = __builtin_amdgcn_cvt_pk_fp8_f32(clamp8(a), clamp8(b), w, false); w = __builtin_amdgcn_cvt_pk_fp8_f32(clamp8(c), clamp8(d), w, true); return (unsigned)w; }
__device__ __forceinline__ float fp8f(unsigned char x) { return __builtin_amdgcn_cvt_f32_fp8((int)x, 0); }
__device__ __forceinline__ float bf2f(unsigned short x) { return __uint_as_float(((unsigned)x) << 16); }
__device__ __forceinline__ float bflo(unsigned w) { return __uint_as_float(w << 16); }
__device__ __forceinline__ float bfhi(unsigned w) { return __uint_as_float(w & 0xffff0000u); }
__device__ __forceinline__ float wave_sum(float v) {
#pragma unroll
    for (int o = 1; o < 64; o <<= 1) v += __shfl_xor(v, o);
    return v;
}
__device__ __forceinline__ bf16x8 pack8(const float* v) { u32x4 p; p.x = pk2(v[0], v[1]); p.y = pk2(v[2], v[3]); p.z = pk2(v[4], v[5]); p.w = pk2(v[6], v[7]); return __builtin_bit_cast(bf16x8, p); }
__device__ __forceinline__ void unpack8(bf16x8 b, float* v) { u32x4 p = __builtin_bit_cast(u32x4, b); v[0] = bflo(p.x); v[1] = bfhi(p.x); v[2] = bflo(p.y); v[3] = bfhi(p.y); v[4] = bflo(p.z); v[5] = bfhi(p.z); v[6] = bflo(p.w); v[7] = bfhi(p.w); }
__device__ __forceinline__ int lane_id_v() { int l; asm volatile("v_mbcnt_lo_u32_b32 %0, -1, 0\n\tv_mbcnt_hi_u32_b32 %0, -1, %0" : "=v"(l)); return l & 63; }
__device__ __forceinline__ int crow(int r, int hi) { return (r & 3) + 8 * (r >> 2) + 4 * hi; }
__device__ __forceinline__ bf16x8 pack_step(const f32x16& x, int s) {
    u32x4 p; p.x = pk2(x[8 * s], x[8 * s + 1]); p.y = pk2(x[8 * s + 2], x[8 * s + 3]); p.z = pk2(x[8 * s + 4], x[8 * s + 5]); p.w = pk2(x[8 * s + 6], x[8 * s + 7]);
    return __builtin_bit_cast(bf16x8, p);
}
__device__ __forceinline__ bf16x8 tr_read2(unsigned a0, unsigned a1) {
    s16x4 lo, hi;
    asm volatile("ds_read_b64_tr_b16 %0, %2\n\tds_read_b64_tr_b16 %1, %3\n\ts_waitcnt lgkmcnt(0)" : "=&v"(lo), "=&v"(hi) : "v"(a0), "v"(a1) : "memory");
    return __builtin_shufflevector(lo, hi, 0, 1, 2, 3, 4, 5, 6, 7);
}

template <int OA, int OB>
__device__ __forceinline__ void tr8(unsigned a, bf16x8 (&f)[4]) {
    s16x4 r0, r1, r2, r3, r4, r5, r6, r7;
    asm volatile("ds_read_b64_tr_b16 %0, %8\n\tds_read_b64_tr_b16 %1, %8 offset:%9\n\tds_read_b64_tr_b16 %2, %8 offset:%10\n\tds_read_b64_tr_b16 %3, %8 offset:%11\n\t"
                 "ds_read_b64_tr_b16 %4, %8 offset:%12\n\tds_read_b64_tr_b16 %5, %8 offset:%13\n\tds_read_b64_tr_b16 %6, %8 offset:%14\n\tds_read_b64_tr_b16 %7, %8 offset:%15\n\ts_waitcnt lgkmcnt(0)"
                 : "=&v"(r0), "=&v"(r1), "=&v"(r2), "=&v"(r3), "=&v"(r4), "=&v"(r5), "=&v"(r6), "=&v"(r7)
                 : "v"(a), "i"(OB), "i"(OA), "i"(OA + OB), "i"(2 * OA), "i"(2 * OA + OB), "i"(3 * OA), "i"(3 * OA + OB) : "memory");
    f[0] = __builtin_shufflevector(r0, r1, 0, 1, 2, 3, 4, 5, 6, 7); f[1] = __builtin_shufflevector(r2, r3, 0, 1, 2, 3, 4, 5, 6, 7);
    f[2] = __builtin_shufflevector(r4, r5, 0, 1, 2, 3, 4, 5, 6, 7); f[3] = __builtin_shufflevector(r6, r7, 0, 1, 2, 3, 4, 5, 6, 7);
}
__device__ __forceinline__ void tr_scan10(unsigned va, unsigned ka, bf16x8& bv, bf16x8 (&ak)[4]) {
    s16x4 v0, v1, r0, r1, r2, r3, r4, r5, r6, r7;
    asm volatile("ds_read_b64_tr_b16 %0, %10\n\tds_read_b64_tr_b16 %1, %10 offset:2112\n\t"
                 "ds_read_b64_tr_b16 %2, %11\n\tds_read_b64_tr_b16 %3, %11 offset:1088\n\tds_read_b64_tr_b16 %4, %11 offset:64\n\tds_read_b64_tr_b16 %5, %11 offset:1152\n\t"
                 "ds_read_b64_tr_b16 %6, %11 offset:128\n\tds_read_b64_tr_b16 %7, %11 offset:1216\n\tds_read_b64_tr_b16 %8, %11 offset:192\n\tds_read_b64_tr_b16 %9, %11 offset:1280\n\ts_waitcnt lgkmcnt(0)"
                 : "=&v"(v0), "=&v"(v1), "=&v"(r0), "=&v"(r1), "=&v"(r2), "=&v"(r3), "=&v"(r4), "=&v"(r5), "=&v"(r6), "=&v"(r7) : "v"(va), "v"(ka) : "memory");
    bv = __builtin_shufflevector(v0, v1, 0, 1, 2, 3, 4, 5, 6, 7);
    ak[0] = __builtin_shufflevector(r0, r1, 0, 1, 2, 3, 4, 5, 6, 7); ak[1] = __builtin_shufflevector(r2, r3, 0, 1, 2, 3, 4, 5, 6, 7);
    ak[2] = __builtin_shufflevector(r4, r5, 0, 1, 2, 3, 4, 5, 6, 7); ak[3] = __builtin_shufflevector(r6, r7, 0, 1, 2, 3, 4, 5, 6, 7);
}
__device__ __forceinline__ void lds_barrier() { asm volatile("s_waitcnt lgkmcnt(0)" ::: "memory"); __builtin_amdgcn_s_barrier(); asm volatile("" ::: "memory"); }
#define MFMA32(a, b, c) __builtin_amdgcn_mfma_f32_32x32x16_bf16((a), (b), (c), 0, 0, 0)

namespace pg8 {
constexpr int BM = 256, BK = 64, HALF = 128, HTB = HALF * BK * 2, STAGE_BYTES = 8 * HTB, NXCD = 8, WGM = 8;
__host__ __device__ __forceinline__ int lds_byte(int r, int c) { const int st = (r >> 4) * 2 + (c >> 5), rr = r & 15, cc = c & 31, ob = rr * 64 + cc * 2; return st * 1024 + (ob ^ (((ob >> 9) & 1) << 5)); }
__host__ __device__ __forceinline__ void stage_rc(int b, int& R, int& C) { const int st = b / 1024, sb = b % 1024, swz = sb ^ (((sb >> 9) & 1) << 5); R = (st >> 1) * 16 + swz / 64; C = (st & 1) * 32 + (swz % 64) / 2; }
__host__ __device__ __forceinline__ int perm32(int rho) { const int n = rho >> 4, i = rho & 15; return 8 * (i >> 2) + 4 * n + (i & 3); }

struct Unit { const char* a; const char* b; char* o; int pm, pn, ldo, z; };

__device__ __forceinline__ void tile_map(int L, int nM, int nN, int& pm, int& pn) {
    const int nwg = nM * nN; int wgid = L;
    { const int q = nwg / NXCD, r = nwg % NXCD, xcd = wgid % NXCD, off = wgid / NXCD; wgid = (xcd < r ? xcd * (q + 1) : r * (q + 1) + (xcd - r) * q) + off; }
    const int nig = WGM * nN, gid = wgid / nig, fm = gid * WGM, gsz = (nM - fm) < WGM ? (nM - fm) : WGM;
    pm = fm + ((wgid % nig) % gsz); pn = (wgid % nig) / gsz;
}

template <class Epi, class Sched, bool ALIGN_EPI, bool FP8 = false, bool GATHER = false>
__device__ __forceinline__ void gemm_phase(LAS unsigned char* lds, const int ldb  , const int nt_arg  , const Sched& S, const Epi& E, const int wid) {
    int nt = nt_arg; asm volatile("" : "+s"(nt));
    const int lane = lane_id_v(), tid = wid * 64 + lane, wr = wid >> 2, wc = wid & 3, fr = lane & 15, fq = lane >> 4;
    unsigned voffA[2], voffB[2];
#pragma unroll
    for (int i = 0; i < 2; ++i) { int R, C; stage_rc(tid * 16 + i * 8192, R, C); const int Rb = (R & ~31) + perm32(R & 31);
        voffA[i] = (unsigned)(R * ldb + C * 2); voffB[i] = (unsigned)(Rb * ldb + C * 2); }
    const size_t kstep = (size_t)(BK * 2);
    const size_t hstep = (size_t)HALF * ldb;
    const unsigned ldsw = (unsigned)wid * 1024u;
    const int aoff = lds_byte(wr * 64 + fr, fq * 8), boff = lds_byte(wc * 32 + fr, fq * 8);
#define PG8_SA(b, h) (((b) * 2 + (h)) * HTB)
#define PG8_SB(b, h) ((4 + (b) * 2 + (h)) * HTB)
#define PG8_STAGE(bufoff, gbase, voff) do { _Pragma("unroll") for (int _i = 0; _i < 2; ++_i) \
        __builtin_amdgcn_global_load_lds((const unsigned*)((const char*)(gbase) + (voff)[_i]), (LAS unsigned*)(lds + (bufoff) + ldsw + _i * 8192), 16, 0, 0); } while (0)
#define PG8_GOFF(slot, half) (LAS u32x2*)(lds + 131072 + ((((slot) & 1) * 2 + (half)) * 512 + tid) * 8)
#define PG8_STAGE_A(bufoff, gbase, half, usenext) do { if constexpr (GATHER) { const u32x2 _go = *PG8_GOFF(ui + ((usenext) ? 1 : 0), half); _Pragma("unroll") for (int _i = 0; _i < 2; ++_i) \
        __builtin_amdgcn_global_load_lds((const unsigned*)((const char*)(gbase) + _go[_i]), (LAS unsigned*)(lds + (bufoff) + ldsw + _i * 8192), 16, 0, 0); } \
        else { PG8_STAGE(bufoff, (const char*)(gbase) + (half) * hstep, voffA); } } while (0)
#define PG8_LDA(dst, b, h) do { _Pragma("unroll") for (int m = 0; m < 4; ++m) { if constexpr (FP8) dst##8[m] = __builtin_shufflevector(*(const LAS i32x4*)(lds + PG8_SA(b, h) + aoff + m * 2048), *(const LAS i32x4*)(lds + PG8_SA(b, h) + aoff + m * 2048 + 1024), 0, 1, 2, 3, 4, 5, 6, 7); \
        else { _Pragma("unroll") for (int k = 0; k < 2; ++k) dst[m][k] = *(const LAS bf16x8*)(lds + PG8_SA(b, h) + aoff + m * 2048 + k * 1024); } } } while (0)
#define PG8_LDB(dst, b, h) do { _Pragma("unroll") for (int n = 0; n < 2; ++n) { if constexpr (FP8) dst##8[n] = __builtin_shufflevector(*(const LAS i32x4*)(lds + PG8_SB(b, h) + boff + n * 2048), *(const LAS i32x4*)(lds + PG8_SB(b, h) + boff + n * 2048 + 1024), 0, 1, 2, 3, 4, 5, 6, 7); \
        else { _Pragma("unroll") for (int k = 0; k < 2; ++k) dst[n][k] = *(const LAS bf16x8*)(lds + PG8_SB(b, h) + boff + n * 2048 + k * 1024); } } } while (0)
#define PG8_MMA(ai, bj, At, Bt) do { __builtin_amdgcn_s_setprio(1); _Pragma("unroll") for (int m = 0; m < 4; ++m) _Pragma("unroll") for (int n = 0; n < 2; ++n) { \
        if constexpr (FP8) { asm volatile("v_mfma_scale_f32_16x16x128_f8f6f4 %0, %1, %2, %0, %3, %3 op_sel_hi:[0,0,0]" : "+v"(acc[ai][bj][m][n]) : "v"(Bt##8[n]), "v"(At##8[m]), "v"(sc1)); } \
        else { _Pragma("unroll") for (int k = 0; k < 2; ++k) acc[ai][bj][m][n] = __builtin_amdgcn_mfma_f32_16x16x32_bf16(Bt[n][k], At[m][k], acc[ai][bj][m][n], 0, 0, 0); } } \
        __builtin_amdgcn_s_setprio(0); } while (0)
#define PG8_WAIT_V(n) asm volatile("s_waitcnt vmcnt(" #n ")" ::: "memory")
#define PG8_WAIT_L(n) asm volatile("s_waitcnt lgkmcnt(" #n ")" ::: "memory")
#define PG8_BAR __builtin_amdgcn_s_barrier()
#define PG8_SCHED __builtin_amdgcn_sched_barrier(0)
    Unit cur, nxt; int ui = 0;
    if (!S.next(0, cur)) return;
    f32x4 acc[2][2][4][2];
#pragma unroll
    for (int a = 0; a < 2; ++a)
#pragma unroll
        for (int b = 0; b < 2; ++b)
#pragma unroll
            for (int m = 0; m < 4; ++m)
#pragma unroll
                for (int n = 0; n < 2; ++n) acc[a][b][m][n] = (f32x4){0.f, 0.f, 0.f, 0.f};
    int sc1 = 0x7f7f7f7f; asm volatile("" : "+v"(sc1));
    bf16x8 At[4][2], B0[2][2], B1[2][2]; i32x8 At8[4], B08[2], B18[2]; (void)At; (void)B0; (void)B1; (void)At8; (void)B08; (void)B18;
    const char* cA = cur.a; const char* cB = cur.b;
    if constexpr (GATHER) { S.rs_fill(cur, tid);
#pragma unroll
        for (int hf = 0; hf < 2; ++hf) { u32x2 go;
#pragma unroll
            for (int i = 0; i < 2; ++i) { int R, C; stage_rc(tid * 16 + i * 8192, R, C); go[i] = (unsigned)S.rowtok(cur, hf * HALF + R) * (unsigned)ldb + (unsigned)(C * 2); }
            *PG8_GOFF(0, hf) = go; } }
    PG8_STAGE(PG8_SB(0, 0), cB, voffB); PG8_STAGE(PG8_SB(0, 1), cB + hstep, voffB); PG8_STAGE_A(PG8_SA(0, 0), cA, 0, false); PG8_STAGE_A(PG8_SA(0, 1), cA, 1, false);
    if (wr == 1) PG8_BAR;
    PG8_WAIT_V(2); PG8_BAR;
    PG8_STAGE(PG8_SB(1, 0), cB + kstep, voffB); PG8_STAGE_A(PG8_SA(1, 0), cA + kstep, 0, false); PG8_STAGE(PG8_SB(1, 1), cB + hstep + kstep, voffB);
    PG8_WAIT_V(6); PG8_BAR;
    for (;;) {
        const bool has_next = S.next(ui + 1, nxt);
        const char* nA = has_next ? nxt.a : cA; const char* nB = has_next ? nxt.b : cB;
        if constexpr (GATHER) { if (has_next) S.rs_fill(nxt, tid);
#pragma unroll
            for (int hf = 0; hf < 2; ++hf) { u32x2 go;
                if (has_next) {
#pragma unroll
                    for (int i = 0; i < 2; ++i) { int R, C; stage_rc(tid * 16 + i * 8192, R, C); go[i] = (unsigned)S.rowtok(nxt, hf * HALF + R) * (unsigned)ldb + (unsigned)(C * 2); } }
                else go = *PG8_GOFF(ui, hf);
                *PG8_GOFF(ui + 1, hf) = go; } }
#pragma unroll 1
        for (int t = 0; t < nt; t += 2) {
            const bool last = (t == nt - 2);
            const char* a1 = cA + (size_t)(t + 1) * kstep;
            const char* a2 = last ? nA : cA + (size_t)(t + 2) * kstep; const char* b2 = last ? nB : cB + (size_t)(t + 2) * kstep;
            const char* a3 = a2 + kstep; const char* b3 = b2 + kstep;
            PG8_LDB(B0, 0, 0); PG8_LDB(B1, 0, 1); PG8_SCHED; PG8_LDA(At, 0, 0); PG8_STAGE_A(PG8_SA(1, 1), a1, 1, false);
            PG8_WAIT_V(8); PG8_WAIT_L(0); PG8_BAR; PG8_MMA(0, 0, At, B0); PG8_MMA(0, 1, At, B1); PG8_BAR; PG8_SCHED;
            PG8_LDA(At, 0, 1); PG8_STAGE(PG8_SB(0, 0), b2, voffB); PG8_STAGE(PG8_SB(0, 1), b2 + hstep, voffB); PG8_STAGE_A(PG8_SA(0, 0), a2, 0, last);
            PG8_WAIT_V(8); PG8_WAIT_L(0); PG8_BAR; PG8_MMA(1, 0, At, B0); PG8_MMA(1, 1, At, B1); PG8_BAR; PG8_SCHED;
            PG8_LDB(B0, 1, 0); PG8_LDB(B1, 1, 1); PG8_SCHED; PG8_LDA(At, 1, 0); PG8_STAGE_A(PG8_SA(0, 1), a2, 1, last);
            PG8_WAIT_V(8); PG8_WAIT_L(0); PG8_BAR; PG8_MMA(0, 0, At, B0); PG8_MMA(0, 1, At, B1); PG8_BAR; PG8_SCHED;
            PG8_LDA(At, 1, 1); PG8_STAGE(PG8_SB(1, 0), b3, voffB); PG8_STAGE(PG8_SB(1, 1), b3 + hstep, voffB); PG8_STAGE_A(PG8_SA(1, 0), a3, 0, last);
            PG8_WAIT_V(8); PG8_WAIT_L(0); PG8_BAR; PG8_MMA(1, 0, At, B0); PG8_MMA(1, 1, At, B1); PG8_BAR; PG8_SCHED;
        }
        if constexpr (ALIGN_EPI) { if (wr == 0) PG8_BAR; }
        if constexpr (FP8) asm volatile("s_nop 15\n\ts_nop 15" ::: "memory");
        if constexpr (!Epi::AFTER_DRAIN) { E(acc, cur, wr, wc, fr, fq); }
        if (!has_next) break;
#pragma unroll
        for (int a = 0; a < 2; ++a)
#pragma unroll
            for (int b = 0; b < 2; ++b)
#pragma unroll
                for (int m = 0; m < 4; ++m)
#pragma unroll
                    for (int n = 0; n < 2; ++n) acc[a][b][m][n] = (f32x4){0.f, 0.f, 0.f, 0.f};
        cur = nxt; cA = nA; cB = nB; ++ui;
        if constexpr (ALIGN_EPI) { if (wr == 1) PG8_BAR; }
    }
    PG8_WAIT_V(0);
    if constexpr (!ALIGN_EPI) { if (wr == 0) PG8_BAR; }
    PG8_BAR;
    if constexpr (Epi::AFTER_DRAIN) { if constexpr (FP8) asm volatile("s_nop 15\n\ts_nop 15" ::: "memory"); E.fused(acc, cur, wr, wc, fr, fq, lds, wid, lane); }
#undef PG8_SA
#undef PG8_SB
#undef PG8_STAGE
#undef PG8_STAGE_A
#undef PG8_GOFF
#undef PG8_LDA
#undef PG8_LDB
#undef PG8_MMA
#undef PG8_WAIT_V
#undef PG8_WAIT_L
#undef PG8_BAR
#undef PG8_SCHED
}

typedef f32x4 Acc[2][2][4][2];

struct EpiStore {
    static constexpr bool AFTER_DRAIN = false;
    const float* cs; float sc;
    __device__ __forceinline__ void operator()(const Acc& acc, const Unit& u, int wr, int wc, int fr, int fq) const {
        bf16_t* base = (bf16_t*)u.o; int r0 = wr * 64 + fr; asm volatile("" : "+v"(r0)); const int c0 = wc * 32 + 8 * fq;
        f32x4 s[2][2];
#pragma unroll
        for (int bj = 0; bj < 2; ++bj)
#pragma unroll
            for (int n = 0; n < 2; ++n) { s[bj][n] = (f32x4){1.f, 1.f, 1.f, 1.f}; if (u.z == 0) { s[bj][n] = (f32x4){sc, sc, sc, sc}; if (cs) s[bj][n] = s[bj][n] * *(const f32x4*)(cs + u.pn * 256 + bj * HALF + c0 + 4 * n); } }
#pragma unroll
        for (int ai = 0; ai < 2; ++ai)
#pragma unroll
            for (int m = 0; m < 4; ++m) { bf16_t* rowp = base + (size_t)(r0 + ai * HALF + m * 16) * u.ldo + c0;
#pragma unroll
                for (int bj = 0; bj < 2; ++bj) { const f32x4 v0 = acc[ai][bj][m][0] * s[bj][0], v1 = acc[ai][bj][m][1] * s[bj][1];
                    u32x4 w; w.x = pk2(v0[0], v0[1]); w.y = pk2(v0[2], v0[3]); w.z = pk2(v1[0], v1[1]); w.w = pk2(v1[2], v1[3]);
                    *(u32x4*)(rowp + bj * HALF) = w; } }
    }
};
struct EpiStore8 {
    static constexpr bool AFTER_DRAIN = false;
    const float* cs; float sc0, sc1;
    __device__ __forceinline__ void operator()(const Acc& acc, const Unit& u, int wr, int wc, int fr, int fq) const {
        unsigned char* base = (unsigned char*)u.o; int r0 = wr * 64 + fr; asm volatile("" : "+v"(r0)); const int c0 = wc * 32 + 8 * fq;
        f32x4 s[2][2];
#pragma unroll
        for (int bj = 0; bj < 2; ++bj)
#pragma unroll
            for (int n = 0; n < 2; ++n) { s[bj][n] = (f32x4){sc1, sc1, sc1, sc1}; if (u.z == 0) s[bj][n] = *(const f32x4*)(cs + u.pn * 256 + bj * HALF + c0 + 4 * n) * sc0; }
#pragma unroll
        for (int ai = 0; ai < 2; ++ai)
#pragma unroll
            for (int m = 0; m < 4; ++m) { unsigned char* rowp = base + (size_t)(r0 + ai * HALF + m * 16) * u.ldo + c0;
#pragma unroll
                for (int bj = 0; bj < 2; ++bj) { const f32x4 v0 = acc[ai][bj][m][0] * s[bj][0], v1 = acc[ai][bj][m][1] * s[bj][1];
                    u32x2 w; w.x = pk4_fp8(v0[0], v0[1], v0[2], v0[3]); w.y = pk4_fp8(v1[0], v1[1], v1[2], v1[3]); *(u32x2*)(rowp + bj * HALF) = w; } }
    }
};
struct EpiRes1 {
    static constexpr bool AFTER_DRAIN = false;
    const float* x; bf16_t* h1b; unsigned char* h1f8; float* ssq;
    __device__ __forceinline__ void operator()(const Acc& acc, const Unit& u, int wr, int wc, int fr, int fq) const {
        asm volatile("" : "+v"(fr)); const int c0 = u.pn * 256 + wc * 32 + 8 * fq;
#pragma unroll
        for (int ai = 0; ai < 2; ++ai) {
            f32x4 xv[4][2][2];
#pragma unroll
            for (int m = 0; m < 4; ++m) { const size_t off = (size_t)(u.pm * 256 + ai * HALF + wr * 64 + m * 16 + fr) * DM + c0;
#pragma unroll
                for (int bj = 0; bj < 2; ++bj) { xv[m][bj][0] = *(const f32x4*)(x + off + bj * HALF); xv[m][bj][1] = *(const f32x4*)(x + off + bj * HALF + 4); } }
#pragma unroll
            for (int m = 0; m < 4; ++m) { const int grow = u.pm * 256 + ai * HALF + wr * 64 + m * 16 + fr; const size_t off = (size_t)grow * DM + c0; float ss = 0.f;
#pragma unroll
                for (int bj = 0; bj < 2; ++bj) { const f32x4 v0 = acc[ai][bj][m][0] + xv[m][bj][0], v1 = acc[ai][bj][m][1] + xv[m][bj][1];
                    u32x4 w; w.x = pk2(v0[0], v0[1]); w.y = pk2(v0[2], v0[3]); w.z = pk2(v1[0], v1[1]); w.w = pk2(v1[2], v1[3]);
                    *(u32x4*)(h1b + off + bj * HALF) = w;
                    { u32x2 w8; w8.x = pk4_fp8(v0[0], v0[1], v0[2], v0[3]); w8.y = pk4_fp8(v1[0], v1[1], v1[2], v1[3]); *(u32x2*)(h1f8 + off + bj * HALF) = w8; }
                    ss += (v0[0] * v0[0] + v0[1] * v0[1]) + (v0[2] * v0[2] + v0[3] * v0[3]) + (v1[0] * v1[0] + v1[1] * v1[1]) + (v1[2] * v1[2] + v1[3] * v1[3]); }
                ss += __shfl_xor(ss, 16); ss += __shfl_xor(ss, 32);
                if (fq == 0) ssq[(size_t)grow * 32 + u.pn * 4 + wc] = ss; }
            asm volatile("" ::: "memory");
        }
    }
};
template <bool HN> struct EpiRes2 {
    static constexpr bool AFTER_DRAIN = false; static constexpr float sc = 1.f / (P_SCALE * WVO_SCALE);
    const bf16_t* h1b; bf16_t* ho; unsigned char* hn8; const float* gain;
    __device__ __forceinline__ void operator()(const Acc& acc, const Unit& u, int wr, int wc, int fr, int fq) const {
        asm volatile("" : "+v"(fr)); const int c0 = u.pn * 256 + wc * 32 + 8 * fq;
#pragma unroll
        for (int ai = 0; ai < 2; ++ai) {
            u32x4 xv[4][2];
#pragma unroll
            for (int m = 0; m < 4; ++m) { const size_t off = (size_t)(u.pm * 256 + ai * HALF + wr * 64 + m * 16 + fr) * DM + c0;
#pragma unroll
                for (int bj = 0; bj < 2; ++bj) xv[m][bj] = *(const u32x4*)(h1b + off + bj * HALF); }
#pragma unroll
            for (int m = 0; m < 4; ++m) { const size_t off = (size_t)(u.pm * 256 + ai * HALF + wr * 64 + m * 16 + fr) * DM + c0;
#pragma unroll
                for (int bj = 0; bj < 2; ++bj) { const u32x4 w = xv[m][bj]; const f32x4 v0 = acc[ai][bj][m][0] * sc + (f32x4){bflo(w.x), bfhi(w.x), bflo(w.y), bfhi(w.y)}, v1 = acc[ai][bj][m][1] * sc + (f32x4){bflo(w.z), bfhi(w.z), bflo(w.w), bfhi(w.w)};
                    u32x4 o; o.x = pk2(v0[0], v0[1]); o.y = pk2(v0[2], v0[3]); o.z = pk2(v1[0], v1[1]); o.w = pk2(v1[2], v1[3]);
                    *(u32x4*)(ho + off + bj * HALF) = o;
                    if constexpr (HN) { const f32x4 g0 = *(const f32x4*)(gain + c0 + bj * HALF), g1 = *(const f32x4*)(gain + c0 + bj * HALF + 4); u32x2 w8; w8.x = pk4_fp8(v0[0] * g0[0], v0[1] * g0[1], v0[2] * g0[2], v0[3] * g0[3]); w8.y = pk4_fp8(v1[0] * g1[0], v1[1] * g1[1], v1[2] * g1[2], v1[3] * g1[3]);
                        *(u32x2*)(hn8 + off + bj * HALF) = w8; } } }
            asm volatile("" ::: "memory");
        }
    }
};
struct EpiHid {
    static constexpr bool AFTER_DRAIN = false;
    const LAS float* rs;
    __device__ __forceinline__ void operator()(const Acc& acc, const Unit& u, int wr, int wc, int fr, int fq) const {
        unsigned char* base = (unsigned char*)u.o; int r0 = wr * 64 + fr; asm volatile("" : "+v"(r0)); const int c0 = wc * 32 + 8 * fq;
#pragma unroll
        for (int ai = 0; ai < 2; ++ai)
#pragma unroll
            for (int m = 0; m < 4; ++m) { unsigned char* rowp = base + (size_t)(r0 + ai * HALF + m * 16) * u.ldo + c0; float h[8]; const float rsv = rs[u.z * 256 + r0 + ai * HALF + m * 16] * (1.f / W_SCALE);
#pragma unroll
                for (int n = 0; n < 2; ++n)
#pragma unroll
                    for (int j = 0; j < 4; ++j) { const float g = acc[ai][0][m][n][j] * rsv, up = acc[ai][1][m][n][j] * (rsv * HID_SCALE); h[4 * n + j] = g * up / (1.f + __expf(-g)); }
                u32x2 w; w.x = pk4_fp8(h[0], h[1], h[2], h[3]); w.y = pk4_fp8(h[4], h[5], h[6], h[7]);
                *(u32x2*)rowp = w; }
    }
};
struct EpiSoftmax {
    static constexpr bool AFTER_DRAIN = true;
    const float* ssq; unsigned char* P;
    __device__ __forceinline__ void fused(Acc& acc, const Unit& u, int wr, int wc, int fr, int fq, LAS unsigned char* lds, int wid, int lane) const {
        LAS float* R1 = (LAS float*)lds; LAS float* R2 = (LAS float*)(lds + 4096);
#pragma unroll
        for (int ai = 0; ai < 2; ++ai)
#pragma unroll
            for (int m = 0; m < 4; ++m) { const int row = ai * HALF + wr * 64 + m * 16 + fr; const int grow = u.pm * 256 + row;
                const f32x4* sp = (const f32x4*)(ssq + (size_t)grow * 32); f32x4 t = sp[0];
#pragma unroll
                for (int i = 1; i < 8; ++i) t = t + sp[i];
                const float rstd = rsqrtf(((t[0] + t[1]) + (t[2] + t[3])) * (1.f / DM) + EPS) * (1.f / WQK_SCALE); float mx = -3.0e38f;
#pragma unroll
                for (int bj = 0; bj < 2; ++bj)
#pragma unroll
                    for (int n = 0; n < 2; ++n) { f32x4 v = acc[ai][bj][m][n] * rstd; acc[ai][bj][m][n] = v; mx = fmaxf(mx, fmaxf(fmaxf(v[0], v[1]), fmaxf(v[2], v[3]))); }
                mx = fmaxf(mx, __shfl_xor(mx, 16)); mx = fmaxf(mx, __shfl_xor(mx, 32));
                if (fq == 0) R1[row * 4 + wc] = mx; }
        __syncthreads();
#pragma unroll
        for (int ai = 0; ai < 2; ++ai)
#pragma unroll
            for (int m = 0; m < 4; ++m) { const int row = ai * HALF + wr * 64 + m * 16 + fr; const f32x4 q = *(const LAS f32x4*)(R1 + row * 4);
                const float M = fmaxf(fmaxf(q[0], q[1]), fmaxf(q[2], q[3])); float sm = 0.f;
#pragma unroll
                for (int bj = 0; bj < 2; ++bj)
#pragma unroll
                    for (int n = 0; n < 2; ++n) { f32x4 v = acc[ai][bj][m][n]; v[0] = __expf(v[0] - M); v[1] = __expf(v[1] - M); v[2] = __expf(v[2] - M); v[3] = __expf(v[3] - M); acc[ai][bj][m][n] = v; sm += (v[0] + v[1]) + (v[2] + v[3]); }
                sm += __shfl_xor(sm, 16); sm += __shfl_xor(sm, 32);
                if (fq == 0) R2[row * 4 + wc] = sm; }
        __syncthreads();
        const int c0 = u.pn * 256 + wc * 32 + 8 * fq;
#pragma unroll
        for (int ai = 0; ai < 2; ++ai)
#pragma unroll
            for (int m = 0; m < 4; ++m) { const int row = ai * HALF + wr * 64 + m * 16 + fr; const int grow = u.pm * 256 + row; const f32x4 q = *(const LAS f32x4*)(R2 + row * 4);
                const float inv = P_SCALE / ((q[0] + q[1]) + (q[2] + q[3]));
#pragma unroll
                for (int bj = 0; bj < 2; ++bj) { const f32x4 v0 = acc[ai][bj][m][0] * inv, v1 = acc[ai][bj][m][1] * inv;
                    u32x2 w; w.x = pk4_fp8(v0[0], v0[1], v0[2], v0[3]); w.y = pk4_fp8(v1[0], v1[1], v1[2], v1[3]);
                    *(u32x2*)(P + (size_t)grow * 1024 + c0 + bj * HALF) = w; } }
        __syncthreads();
    }
};
}
using pg8::Unit;


#define XB_TMO      128
#define XB_XCNT(j)  (256  + 64 * (j))
#define XB_XSUB(j)  (1280 + 64 * (j))
#define XB_XGEN(j)  (2304 + 64 * (j))
#define XB_TOP      3328
#define XB_TOPGEN   3392
#define XCD_BAR_WORDS 3456
#define XB_SPIN_CAP (1u << 22)
__device__ __forceinline__ unsigned xb_ld(unsigned* p)              { return __hip_atomic_load(p, __ATOMIC_RELAXED, __HIP_MEMORY_SCOPE_AGENT); }
__device__ __forceinline__ unsigned xb_add(unsigned* p, unsigned v) { return __hip_atomic_fetch_add(p, v, __ATOMIC_RELAXED, __HIP_MEMORY_SCOPE_AGENT); }
__device__ __forceinline__ unsigned xb_xcc_id() { return (unsigned)__builtin_amdgcn_s_getreg((3 << 11) | 20) & 0xFu; }
#define XB_SPIN(cond, bar) do { unsigned _sp = 0; while (cond) { __builtin_amdgcn_s_sleep(1); \
    if ((++_sp & 255u) == 0u) { if (xb_ld(&(bar)[XB_TMO])) break; if (_sp > XB_SPIN_CAP) { atomicAdd(&(bar)[XB_TMO], 1u); break; } } } } while (0)
struct XcdBarrier { unsigned* bar; unsigned x; volatile LAS unsigned* st; };
__device__ __forceinline__ XcdBarrier xcd_barrier_post(unsigned* bar, volatile LAS unsigned* st, bool leader) {
    XcdBarrier b; b.bar = bar; b.x = xb_xcc_id(); b.st = st;
    if (leader) (void)xb_add(&bar[XB_XCNT(b.x)], 1u);
    return b;
}
__device__ __forceinline__ void xcd_barrier_complete(unsigned* bar, unsigned x, unsigned& nloc, unsigned& nx) {
    const unsigned G = gridDim.x * gridDim.y * gridDim.z;
    unsigned sum, cnt, mine, sp = 0u;
    for (;;) {
        sum = 0u; cnt = 0u; mine = 0u;
#pragma unroll
        for (unsigned j = 0; j < 16; ++j) { const unsigned c = xb_ld(&bar[XB_XCNT(j)]); sum += c; cnt += (c > 0u) ? 1u : 0u; mine = (j == x) ? c : mine; }
        if (sum == G) break;
        __builtin_amdgcn_s_sleep(1);
        if ((++sp & 255u) == 0u) { if (xb_ld(&bar[XB_TMO])) break; if (sp > XB_SPIN_CAP) { atomicAdd(&bar[XB_TMO], 1u); break; } }
    }
    nloc = mine > 0u ? mine : 1u; nx = cnt > 0u ? cnt : 1u;
}
__device__ __forceinline__ void xcd_barrier(const XcdBarrier& b, int wave_) {
    asm volatile("s_waitcnt vmcnt(0)" ::: "memory");
    __syncthreads();
    if (wave_ == 0 && lane_id_v() == 0) {
        unsigned* bar = b.bar;
        __builtin_amdgcn_s_waitcnt(0);
        unsigned nloc = b.st[0], nx = b.st[1];
        if (nloc == 0u) { xcd_barrier_complete(bar, b.x, nloc, nx); b.st[0] = nloc; b.st[1] = nx; }
        const unsigned old = xb_add(&bar[XB_XSUB(b.x)], 1u);
        const unsigned gen = old / nloc;
        if (old + 1u == (gen + 1u) * nloc) {
            __builtin_amdgcn_fence(__ATOMIC_RELEASE, "agent");
            asm volatile("s_waitcnt vmcnt(0)" ::: "memory");
            const unsigned og = xb_add(&bar[XB_TOP], 1u);
            const unsigned tg = og / nx;
            if (og + 1u == (tg + 1u) * nx) xb_add(&bar[XB_TOPGEN], 1u);
            else XB_SPIN(xb_ld(&bar[XB_TOPGEN]) == tg, bar);
            __builtin_amdgcn_fence(__ATOMIC_ACQUIRE, "agent");
            xb_add(&bar[XB_XGEN(b.x)], 1u);
            asm volatile("s_waitcnt vmcnt(0)" ::: "memory");
        } else {
            XB_SPIN(xb_ld(&bar[XB_XGEN(b.x)]) == gen, bar);
            __builtin_amdgcn_fence(__ATOMIC_ACQUIRE, "agent");
            asm volatile("s_waitcnt vmcnt(0)" ::: "memory");
        }
    }
    __syncthreads();
}

struct Params {
    const float *x, *mem, *norm_mix, *w_in, *attn_out_norm, *sink_logit, *w_gla_gf, *b_gla_gf, *w_gla_gb, *b_gla_gb, *gla_out_norm, *w_out, *norm_cross, *norm_mem,
        *w_cq, *w_ck, *w_cv, *w_co, *norm_ffn, *w_rg, *b_rg, *w_re, *b_re, *w_gate, *w_up, *w_down, *norm_final;
    float* out; unsigned char* ws; int ph_lo, ph_hi;
};

template <class RowMap>
__device__ __forceinline__ void tr_item(const float* W, int N, int Nvalid, int k0, int n0, bf16_t* dst, int Kd, const RowMap& rm, LAS float* scr, int lane) {
    const bool ok = (n0 + lane) < Nvalid; const int nc = ok ? n0 + lane : Nvalid - 1; const float* src = W + (size_t)k0 * N + nc;
    float vv[64];
#pragma unroll
    for (int kk = 0; kk < 64; ++kk) vv[kk] = src[(size_t)kk * N];
#pragma unroll
    for (int kk = 0; kk < 64; ++kk) scr[kk * 65 + lane] = ok ? vv[kk] : 0.f;
    asm volatile("s_waitcnt lgkmcnt(0)" ::: "memory");
    const int c = lane & 7;
#pragma unroll
    for (int j = 0; j < 8; ++j) { const int n = (lane >> 3) + 8 * j; const LAS float* s = scr + (8 * c) * 65 + n;
        u32x4 o; o.x = pk2(s[0], s[65]); o.y = pk2(s[2 * 65], s[3 * 65]); o.z = pk2(s[4 * 65], s[5 * 65]); o.w = pk2(s[6 * 65], s[7 * 65]);
        *(u32x4*)(dst + (size_t)rm(n0 + n) * Kd + k0 + 8 * c) = o; }
    asm volatile("s_waitcnt lgkmcnt(0)" ::: "memory");
}
template <class RowMap>
__device__ __forceinline__ void tr_item8(const float* W, int N, int k0, int n0, unsigned char* dst, int Kd, const RowMap& rm, float scale, LAS float* scr, int lane, bool nostore = false) {
    LAS unsigned* s32 = (LAS unsigned*)scr;
    {
        const int n4 = lane & 15, ks = lane >> 4; const float* src = W + (size_t)(k0 + 2 * ks) * N + n0 + 4 * n4;
        f32x4 va[16], vb[16];
#pragma unroll
        for (int i = 0; i < 16; ++i) { va[i] = __builtin_nontemporal_load((const f32x4*)(src + (size_t)(8 * i) * N)); vb[i] = __builtin_nontemporal_load((const f32x4*)(src + (size_t)(8 * i + 1) * N)); }
#pragma unroll
        for (int i = 0; i < 16; ++i)
#pragma unroll
            for (int e = 0; e < 4; ++e) s32[(4 * i + ks) * 65 + 4 * n4 + e] = pk2(va[i][e], vb[i][e]); }
    asm volatile("s_waitcnt lgkmcnt(0)" ::: "memory");
    const int c = lane & 7;
#pragma unroll
    for (int j = 0; j < 8; ++j) { const int n = (lane >> 3) + 8 * j; const LAS unsigned* s = s32 + (8 * c) * 65 + n; unsigned w[8];
#pragma unroll
        for (int i = 0; i < 8; ++i) w[i] = s[i * 65];
        u32x4 o;
        o.x = pk4_fp8(bflo(w[0]) * scale, bfhi(w[0]) * scale, bflo(w[1]) * scale, bfhi(w[1]) * scale); o.y = pk4_fp8(bflo(w[2]) * scale, bfhi(w[2]) * scale, bflo(w[3]) * scale, bfhi(w[3]) * scale);
        o.z = pk4_fp8(bflo(w[4]) * scale, bfhi(w[4]) * scale, bflo(w[5]) * scale, bfhi(w[5]) * scale); o.w = pk4_fp8(bflo(w[6]) * scale, bfhi(w[6]) * scale, bflo(w[7]) * scale, bfhi(w[7]) * scale);
        if (!nostore || (o.x == 0x12345678u && o.y == 0x9abcdef0u)) __builtin_nontemporal_store(o, (u32x4*)(dst + (size_t)rm(n0 + n) * Kd + k0 + 16 * c)); }
    asm volatile("s_waitcnt lgkmcnt(0)" ::: "memory");
}
struct RmId { int off; __device__ __forceinline__ int operator()(int n) const { return off + n; } };
struct RmGu { int base; __device__ __forceinline__ int operator()(int n) const { return base + (n >> 7) * 256 + (n & 127); } };

struct SchedP1 {
    int G, c; const char *u, *win, *memn, *wckv; char *proj, *memK, *memV;
    __device__ __forceinline__ bool next(int i, Unit& t) const {
        int L = i * G + c;
        if (L < 1216) { int pm, pn; pg8::tile_map(L, 64, 19, pm, pn); t.a = u + (size_t)pm * 256 * DM * 2; t.b = win + (size_t)pn * 256 * DM * 2; t.o = proj + ((size_t)pm * 256 * PLD + pn * 256) * 2; t.pm = pm; t.pn = pn; t.ldo = PLD; t.z = 1; return true; }
        L -= 1216; if (L >= 64) return false;
        const int pm = L & 3, pn = L >> 2; t.a = memn + (size_t)pm * 256 * DM * 2; t.b = wckv + (size_t)pn * 256 * DM * 2;
        t.o = (pn < 8 ? memK : memV) + ((size_t)pm * 256 * DM + (pn & 7) * 256) * 2; t.pm = pm; t.pn = pn; t.ldo = DM; t.z = 1; return true;
    }
};
struct SchedPre {
    int G, c; const char *memK, *memV, *wcq, *wco; char *wqk, *wvo;
    __device__ __forceinline__ bool next(int i, Unit& t) const {
        int L = i * G + c; if (L >= 256 * PRE_REP) return false;
        L &= 255;
        const int q = L & 127, b = q >> 5, h = (q >> 3) & 3, ct = q & 7;
        if (L < 128) { t.a = memK + ((size_t)b * 256 * DM + h * 512) * 2; t.b = wcq + ((size_t)ct * 256 * DM + h * 512) * 2; t.o = wqk + (((size_t)b * 1024 + h * 256) * DM + ct * 256); t.pm = 0; t.pn = ct; t.ldo = DM; t.z = 0; }
        else { t.a = wco + ((size_t)ct * 256 * DM + h * 512) * 2; t.b = memV + ((size_t)b * 256 * DM + h * 512) * 2; t.o = wvo + (((size_t)b * 2048 + ct * 256) * 1024 + h * 256); t.pm = 0; t.pn = 0; t.ldo = 1024; t.z = 1; }
        return true;
    }
};
struct SchedTok {
    int G, c, nN; const char *A, *B; size_t astride  , bstride_tile  , bstride_batch;
    __device__ __forceinline__ bool next(int i, Unit& t) const {
        const int L = i * G + c; if (L >= 64 * nN) return false;
        int pm, pn; pg8::tile_map(L, 64, nN, pm, pn);
        t.a = A + (size_t)pm * astride; t.b = B + (size_t)(pm >> 4) * bstride_batch + (size_t)pn * bstride_tile; t.o = nullptr; t.pm = pm; t.pn = pn; t.ldo = 0; t.z = 0; return true;
    }
};
struct SchedOne { Unit u0; __device__ __forceinline__ bool next(int i, Unit& t) const { if (i > 0) return false; t = u0; return true; } };
struct SchedMoe {
    const LAS int* T; const int* list; const float* rstd3; LAS float* rs;
    int G, c, nblk; const LAS int* blk_e; const char *A, *B; char* O; size_t astride, bexp, btile, ostride; int ocol  , ldo, reps;
    __device__ __forceinline__ bool next(int i, Unit& t) const {
        int L = i * G + c; if (L >= nblk * 8 * reps) return false;
        if (L >= nblk * 8) L -= nblk * 8;
        int pm, pn; pg8::tile_map(L, nblk, 8, pm, pn); const int e = __builtin_amdgcn_readfirstlane(blk_e[pm]);
        t.a = A + (size_t)pm * astride; t.b = B + (size_t)e * bexp + (size_t)pn * btile; t.o = O + (size_t)pm * ostride + (size_t)pn * ocol; t.pm = pm; t.pn = pn; t.ldo = ldo; t.z = list ? i % 3 : 1; return true;
    }
    __device__ __forceinline__ int rowtok(const Unit& u, int r) const { const int e = __builtin_amdgcn_readfirstlane(blk_e[u.pm]); const int idx = (u.pm - __builtin_amdgcn_readfirstlane(T[1 + e])) * 256 + r; const int cnt = __builtin_amdgcn_readfirstlane(T[240 + e]);
        return idx < cnt ? list[e * 16384 + idx] : 0; }
    __device__ __forceinline__ void rs_fill(const Unit& u, int tid) const { if (tid < 256) rs[u.z * 256 + tid] = rstd3[rowtok(u, tid)]; }
};

__device__ __forceinline__ void moe_table(const unsigned* cnt, LAS int* T, int tid_) {
    if (tid_ == 0) { int acc = 0;
        for (int e = 0; e < NEXP; ++e) { T[1 + e] = acc; T[240 + e] = (int)cnt[e]; const int nb = ((int)cnt[e] + 255) >> 8; for (int j = 0; j < nb; ++j) T[64 + acc + j] = e; acc += nb; }
        T[1 + NEXP] = acc; T[0] = acc; }
    __syncthreads();
}

__global__ void __launch_bounds__(512, 2) fwd_mega(Params p) {
    extern __shared__ __attribute__((aligned(16))) unsigned char lds_raw[];
    LAS unsigned char* lds = (LAS unsigned char*)lds_raw;
    const unsigned ldsb = (unsigned)(size_t)lds;
    const int wave = __builtin_amdgcn_readfirstlane((int)threadIdx.x >> 6);
#define PH_IDS const int lane = lane_id_v(), tid = wave * 64 + lane; (void)tid; (void)lane;
    const int G = gridDim.x, bid = blockIdx.x;
    const int gw = bid * 8 + wave, NGW = G * 8;
    unsigned char* const ws = p.ws;
#define WGU ((unsigned char*)(ws + WS_WGU))
#define WD ((unsigned char*)(ws + WS_WD))
#define WIN ((bf16_t*)(ws + WS_WIN))
#define WCKV ((bf16_t*)(ws + WS_WCKV))
#define WOUT ((bf16_t*)(ws + WS_WOUT))
#define WCO ((bf16_t*)(ws + WS_WCO))
#define WCQ ((bf16_t*)(ws + WS_WCQ))
#define WQK ((unsigned char*)(ws + WS_WQK))
#define WVO ((unsigned char*)(ws + WS_WVO))
#define U ((bf16_t*)(ws + WS_U))
#define H1B ((bf16_t*)(ws + WS_H1B))
#define H1F8 ((unsigned char*)(ws + WS_H1F8))
#define HN8 ((unsigned char*)(ws + WS_H1F8))
#define LIST ((int*)(ws + WS_FIMG))
#define MEMN ((bf16_t*)(ws + WS_MEMN))
#define MEMK ((bf16_t*)(ws + WS_MEMK))
#define MEMV ((bf16_t*)(ws + WS_MEMV))
#define PROJ ((bf16_t*)(ws + WS_PROJ))
#define PB ((unsigned char*)(ws + WS_P))
#define GQ ((bf16_t*)(ws + WS_GQ))
#define GK ((bf16_t*)(ws + WS_GK))
#define GD ((float*)(ws + WS_GD))
#define O1 ((bf16_t*)(ws + WS_O1))
#define O2 ((bf16_t*)(ws + WS_O2))
#define O3 ((bf16_t*)(ws + WS_O3))
#define A2 ((bf16_t*)(ws + WS_A2))
#define SSQ ((float*)(ws + WS_SSQ))
#define XS ((unsigned char*)(ws + WS_XS))
#define HID ((unsigned char*)(ws + WS_HID))
#define YS ((unsigned char*)(ws + WS_YS))
#define WR ((float*)(ws + WS_WR))
#define FIMG ((float*)(ws + WS_FIMG))
#define SEGD ((float*)(ws + WS_SEGD))
#define ASG_E ((int*)(ws + WS_ASG))
#define ASG_S (ASG_E + 2 * NT)
#define ASG_G ((float*)(ASG_S + 2 * NT))
#define RSTD3 (ASG_G + 2 * NT)
#define DEST ((int*)(RSTD3 + NT))
#define CNT ((unsigned*)(ws + WS_CTL) + CW_CNT)
    float* H = p.out;
    LAS int* TBL = (LAS int*)(lds + MISC_OFF);
    const int lo = p.ph_lo, hi = p.ph_hi;
#define IN(k) (lo <= (k) && (k) < hi)
    volatile LAS unsigned* XST = (volatile LAS unsigned*)(lds + MISC_OFF + 4096);
    { PH_IDS if (tid < 4) XST[tid] = 0u;
    __syncthreads();
    }
    XcdBarrier xbar; { PH_IDS xbar = xcd_barrier_post((unsigned*)(ws + WS_CTL) + CW_BAR, XST, tid == 0); }
#define SEAM(k) do { if (IN(k) && IN((k) + 1)) xcd_barrier(xbar, wave); } while (0)

    if (IN(0)) for (int rp_ = 0; rp_ < (RPT == 0 ? 2 : 1); ++rp_) { PH_IDS
        LAS float* scr = (LAS float*)(lds + wave * 16640);
        constexpr int I_IN = 32 * 76, I_SQ = 32 * 32, I_G = 16 * 16, I_D = 8 * 32;
        for (int it = gw; it < (I_IN + 2 * I_SQ) * P0T_REP; it += NGW) {
            int r = it % (I_IN + 2 * I_SQ);
            if (r < I_IN) { const int kb = r / 76, nb = r % 76; tr_item(p.w_in, 4640, 4640, 64 * kb, 64 * nb, WIN, DM, RmId{0}, scr, lane); continue; } r -= I_IN;
            if (r < I_SQ) { tr_item(p.w_ck, DM, DM, 64 * (r >> 5), 64 * (r & 31), WCKV, DM, RmId{0}, scr, lane); continue; } r -= I_SQ;
            tr_item(p.w_cv, DM, DM, 64 * (r >> 5), 64 * (r & 31), WCKV, DM, RmId{2048}, scr, lane);
        }
        {
            f32x4 cv[8], n1[8], n2[8];
            constexpr int NR = NT + NB * MEML;
            auto rowp = [&](int m) -> const f32x4* { return (const f32x4*)(m < NT ? p.x + (size_t)m * DM : p.mem + (size_t)(m - NT) * DM) + 2 * lane; };
            auto rload = [&](int m, f32x4 (&d)[8]) { const f32x4* xr = rowp(m < NR ? m : gw);
#pragma unroll
                for (int j = 0; j < 4; ++j) { d[2 * j] = xr[128 * j]; d[2 * j + 1] = xr[128 * j + 1]; } };
            for (int prr = 0; prr < P0R_REP; ++prr) {
            if (gw < NR) { rload(gw, cv); rload(gw + NGW, n1); }
            for (int m = gw; m < NR; m += NGW) {
                rload(m + 2 * NGW, n2);
                float s = 0.f;
#pragma unroll
                for (int j = 0; j < 8; ++j) s += (cv[j][0] * cv[j][0] + cv[j][1] * cv[j][1]) + (cv[j][2] * cv[j][2] + cv[j][3] * cv[j][3]);
                const float rstd = rsqrtf(wave_sum(s) * (1.f / DM) + EPS);
                const f32x4* gr = (const f32x4*)(m < NT ? p.norm_mix : p.norm_mem) + 2 * lane; u32x4* o = (u32x4*)(m < NT ? U + (size_t)m * DM : MEMN + (size_t)(m - NT) * DM) + lane;
#pragma unroll
                for (int j = 0; j < 4; ++j) { const f32x4 g0 = gr[128 * j], g1 = gr[128 * j + 1]; const f32x4 a = cv[2 * j], c = cv[2 * j + 1]; u32x4 w;
                    w.x = pk2(a[0] * rstd * g0[0], a[1] * rstd * g0[1]); w.y = pk2(a[2] * rstd * g0[2], a[3] * rstd * g0[3]); w.z = pk2(c[0] * rstd * g1[0], c[1] * rstd * g1[1]); w.w = pk2(c[2] * rstd * g1[2], c[3] * rstd * g1[3]);
                    o[64 * j] = w; }
#pragma unroll
                for (int j = 0; j < 8; ++j) { cv[j] = n1[j]; n1[j] = n2[j]; }
            }
            }
        }
        __syncthreads();
    }
    SEAM(0);

    if (IN(1)) for (int rp_ = 0; rp_ < (RPT == 1 ? 2 : 1); ++rp_) { PH_IDS
        SchedP1 S{G, bid, (const char*)U, (const char*)WIN, (const char*)MEMN, (const char*)WCKV, (char*)PROJ, (char*)MEMK, (char*)MEMV};
        pg8::EpiStore E{nullptr, 1.f};
        LAS float* scr = (LAS float*)(lds + wave * 16640);
        constexpr int I_G = 16 * 16, I_D = 8 * 32, NE = NEXP * (2 * I_G + I_D);
        int kdone = 0; const int ktot = (NE * (1 + P0E_REP) - gw + NGW - 1) / NGW;
        struct EDesc { const float* W; unsigned char* dst; int N, Kd, k0, n0, rb, gu; };
        auto edesc = [&](int it) { EDesc d; const int q = it % NE; const int typ = q / (NEXP * 256), e = NEXP - 1 - (q % (NEXP * 256)) / 256, r = q % 256;
            if (typ == 0) { d.W = p.w_down + (size_t)e * DFF * DM; d.N = DM; d.k0 = 128 * (r >> 5); d.n0 = 64 * (r & 31); d.dst = WD + (size_t)e * 2048 * DFF; d.Kd = DFF; d.rb = 0; d.gu = 0; }
            else { d.W = (typ == 1 ? p.w_up : p.w_gate) + (size_t)e * DM * DFF; d.N = DFF; d.k0 = 128 * (r >> 4); d.n0 = 64 * (r & 15); d.dst = WGU + (size_t)e * 2048 * DM; d.Kd = DM; d.rb = (typ == 1) ? 128 : 0; d.gu = 1; }
            return d; };
        auto prep_chunk = [&](int nitems) {
            LAS unsigned* s32 = (LAS unsigned*)scr; const int n4 = lane & 15, ks = lane >> 4, cc = lane & 7;
            int left = ktot - kdone; if (left > nitems) left = nitems;
            if (left > 0) {
                f32x4 va[16], vb[16];
                auto eload = [&](const EDesc& d) { const float* sp = d.W + (size_t)(d.k0 + 2 * ks) * d.N + d.n0 + 4 * n4;
#pragma unroll
                    for (int i = 0; i < 16; ++i) { va[i] = __builtin_nontemporal_load((const f32x4*)(sp + (size_t)(8 * i) * d.N)); vb[i] = __builtin_nontemporal_load((const f32x4*)(sp + (size_t)(8 * i + 1) * d.N)); } };
                EDesc dcur = edesc(gw + kdone * NGW); eload(dcur);
                for (int c = 0; c < left; ++c, ++kdone) {
#pragma unroll
                    for (int i = 0; i < 16; ++i)
#pragma unroll
                        for (int e = 0; e < 4; ++e) s32[(4 * i + ks) * 65 + 4 * n4 + e] = pk2(va[i][e], vb[i][e]);
                    asm volatile("s_waitcnt lgkmcnt(0)" ::: "memory");
                    EDesc dnext = dcur; if (c + 1 < left) { dnext = edesc(gw + (kdone + 1) * NGW); eload(dnext); }
#pragma unroll
                    for (int j = 0; j < 8; ++j) { const int n = (lane >> 3) + 8 * j; const LAS unsigned* s = s32 + (8 * cc) * 65 + n; unsigned w[8];
#pragma unroll
                        for (int i = 0; i < 8; ++i) w[i] = s[i * 65];
                        u32x4 o;
                        o.x = pk4_fp8(bflo(w[0]) * W_SCALE, bfhi(w[0]) * W_SCALE, bflo(w[1]) * W_SCALE, bfhi(w[1]) * W_SCALE); o.y = pk4_fp8(bflo(w[2]) * W_SCALE, bfhi(w[2]) * W_SCALE, bflo(w[3]) * W_SCALE, bfhi(w[3]) * W_SCALE);
                        o.z = pk4_fp8(bflo(w[4]) * W_SCALE, bfhi(w[4]) * W_SCALE, bflo(w[5]) * W_SCALE, bfhi(w[5]) * W_SCALE); o.w = pk4_fp8(bflo(w[6]) * W_SCALE, bfhi(w[6]) * W_SCALE, bflo(w[7]) * W_SCALE, bfhi(w[7]) * W_SCALE);
                        const int nn = dcur.n0 + n; const int row = dcur.gu ? dcur.rb + (nn >> 7) * 256 + (nn & 127) : nn;
                        if (!(P0E_NOSTORE && gw + kdone * NGW >= NE) || o.x == 0x12345678u) __builtin_nontemporal_store(o, (u32x4*)(dcur.dst + (size_t)row * dcur.Kd + dcur.k0 + 16 * cc)); }
                    asm volatile("s_waitcnt lgkmcnt(0)" ::: "memory");
                    dcur = dnext; } }
            __syncthreads(); };
        auto extra_prep = [&]() {
            constexpr int I_SQ = 32 * 32;
            for (int it = gw; it < 2 * I_SQ; it += NGW) { const int r = it & (I_SQ - 1);
                if (it < I_SQ) tr_item(p.w_out, DM, DM, 64 * (r >> 5), 64 * (r & 31), WOUT, DM, RmId{0}, scr, lane); else tr_item(p.w_co, DM, DM, 64 * (r >> 5), 64 * (r & 31), WCO, DM, RmId{0}, scr, lane); }
        for (int i = gw * 64 + lane; i < DM * DM / 8; i += NGW * 64) { const f32x4 a = ((const f32x4*)p.w_cq)[2 * i], b = ((const f32x4*)p.w_cq)[2 * i + 1];
            u32x4 w; w.x = pk2(a[0], a[1]); w.y = pk2(a[2], a[3]); w.z = pk2(b[0], b[1]); w.w = pk2(b[2], b[3]); ((u32x4*)WCQ)[i] = w; }
        for (int i = gw * 64 + lane; i < 128 * 3 * 64; i += NGW * 64) { const int l = i & 63, ct = (i >> 6) % 3, kb = i / 192; const int j = 16 * ct + (l & 15); f32x4 o;
#pragma unroll
            for (int e = 0; e < 4; ++e) { const int k = 16 * kb + 4 * (l >> 4) + e; float w = 0.f; if (j < 4) w = p.w_rg[k * 4 + j]; else if (j < 36) w = p.w_re[k * 32 + (j - 4)]; o[e] = w * p.norm_ffn[k]; }
            ((f32x4*)WR)[i] = o; }
            __syncthreads(); };
        int nun = 0; { Unit t; while (S.next(nun, t)) ++nun; }
        struct SchedRange { const SchedP1* S; int a, b; __device__ __forceinline__ bool next(int i, Unit& t) const { return (a + i < b) && S->next(a + i, t); } };
        int split = 2 * (bid % 3); if (split > nun) split = nun;
        if (split > 0) { SchedRange R{&S, 0, split}; pg8::gemm_phase<pg8::EpiStore, SchedRange, true>(lds, DM * 2, DM / 64, R, E, wave); }
        extra_prep(); prep_chunk(ktot);
        if (split < nun) { SchedRange R{&S, split, nun}; pg8::gemm_phase<pg8::EpiStore, SchedRange, true>(lds, DM * 2, DM / 64, R, E, wave); }
    }
    SEAM(1);

    if (IN(2)) for (int rp_ = 0; rp_ < (RPT == 2 ? 2 : 1); ++rp_) { PH_IDS }

    if (IN(3)) for (int rp_ = 0; rp_ < (RPT == 3 ? 2 : 1); ++rp_) { PH_IDS
        const int r32 = lane & 31, hh = lane >> 5, q4 = (lane & 15) >> 2, p4 = lane & 3, blk = (lane >> 4) & 1;
        {
            constexpr int L_B = 0, L_Q = 32768, L_KI = L_Q + 17408, L_KD = L_KI + 17408, L_V = L_KD + 17408, L_P = L_V + 33792, L_TT = L_P + 9216, L_D = L_TT + 1024;
            static_assert(L_D + 512 <= MISC_OFF, "G1 LDS");
            LAS float* BB_ = (LAS float*)(lds + L_B); LAS float* TT = (LAS float*)(lds + L_TT); LAS float* DD = (LAS float*)(lds + L_D);
            const int gct = wave & 1, gdt = wave >> 1;
            for (int it0 = bid; it0 < 256 * SCAN_REP; it0 += G) { const int it = it0 & 255;
                const int dir = it & 1, h = (it >> 1) & 3, b = (it >> 3) & 3, sg = it >> 5; const int vs = wave;
                const size_t tile0 = (size_t)((b * 4 + h) * 2 + dir) * 64; bf16_t* OUT = dir ? O3 : O2;
                f32x16 St[4];
#pragma unroll
                for (int db = 0; db < 4; ++db)
#pragma unroll
                    for (int i = 0; i < 16; ++i) St[db][i] = 0.f;
                bf16x8 bw; float gbias;
                { const float* wgp = (dir ? p.w_gla_gb : p.w_gla_gf) + h * 128 + 32 * gdt + r32; float wg8[8];
#pragma unroll
                  for (int j = 0; j < 8; ++j) wg8[j] = wgp[(8 * hh + j) * 512];
                  bw = pack8(wg8); gbias = (dir ? p.b_gla_gb : p.b_gla_gf)[h * 128 + 32 * gdt + r32]; }
                float segp = 1.f;
                bf16x8 n_alr, n_pq[2], n_pk[2], n_pv[4];
                auto cload = [&](int n_) { const int t0_ = b * SEQ + n_ * 64;
                    n_alr = *(const bf16x8*)(PROJ + (size_t)(t0_ + 32 * gct + r32) * PLD + C_LRF + 16 * dir + 8 * hh);
#pragma unroll
                    for (int rep = 0; rep < 2; ++rep) { const int pidx = tid + 512 * rep, c = pidx >> 4, d8 = (pidx & 15) * 8; const size_t rowoff = (size_t)(t0_ + c) * PLD + h * 128 + d8;
                        n_pq[rep] = *(const bf16x8*)(PROJ + rowoff + C_QG); n_pk[rep] = *(const bf16x8*)(PROJ + rowoff + C_KG); }
#pragma unroll
                    for (int rep = 0; rep < 4; ++rep) { const int pidx = tid + 512 * rep, row = pidx >> 5, ch = pidx & 31; n_pv[rep] = *(const bf16x8*)(PROJ + (size_t)(t0_ + row) * PLD + C_VG + h * 256 + ch * 8); } };
                cload(dir ? 63 - 8 * sg : 8 * sg);
                for (int i8 = 0; i8 < 8; ++i8) {
                    const int i = 8 * sg + i8; const int n = dir ? 63 - i : i; const int t0 = b * SEQ + n * 64;
                    { f32x16 z;
#pragma unroll
                      for (int q = 0; q < 16; ++q) z[q] = 0.f;
                      f32x16 Gt = MFMA32(n_alr, bw, z);
#pragma unroll
                      for (int q = 0; q < 16; ++q) { const float pre = Gt[q] + gbias; Gt[q] = (fminf(pre, 0.f) - __logf(1.f + __expf(-fabsf(pre)))) * (1.f / 16.f); }
                      float T[4], Uo[4], off[4]; float run = 0.f;
                      if (dir == 0) {
#pragma unroll
                          for (int g = 0; g < 4; ++g) { Gt[4 * g + 1] += Gt[4 * g]; Gt[4 * g + 2] += Gt[4 * g + 1]; Gt[4 * g + 3] += Gt[4 * g + 2]; T[g] = Gt[4 * g + 3]; }
                      } else {
#pragma unroll
                          for (int g = 0; g < 4; ++g) { Gt[4 * g + 2] += Gt[4 * g + 3]; Gt[4 * g + 1] += Gt[4 * g + 2]; Gt[4 * g] += Gt[4 * g + 1]; T[g] = Gt[4 * g]; }
                      }
#pragma unroll
                      for (int g = 0; g < 4; ++g) Uo[g] = __shfl_xor(T[g], 32);
                      if (dir == 0) {
#pragma unroll
                          for (int g = 0; g < 4; ++g) { off[g] = run + (hh ? Uo[g] : 0.f); run += T[g] + Uo[g]; }
                      } else {
#pragma unroll
                          for (int g = 3; g >= 0; --g) { off[g] = run + (hh ? 0.f : Uo[g]); run += T[g] + Uo[g]; }
                      }
                      const int dcol = 32 * gdt + r32;
#pragma unroll
                      for (int q = 0; q < 16; ++q) BB_[(32 * gct + crow(q, hh)) * 128 + dcol] = Gt[q] + off[q >> 2];
                      if (hh == 0) TT[gct * 128 + dcol] = run; }
                    lds_barrier();
#pragma unroll
                    for (int rep = 0; rep < 2; ++rep) { const int pidx = tid + 512 * rep, c = pidx >> 4, d8 = (pidx & 15) * 8;
                        float q[8], k[8]; unpack8(n_pq[rep], q); unpack8(n_pk[rep], k);
                        const LAS float* Bd = BB_ + c * 128 + d8; const f32x4 b0 = *(const LAS f32x4*)Bd, b1 = *(const LAS f32x4*)(Bd + 4);
                        const f32x4 ta0 = *(const LAS f32x4*)(TT + d8), ta1 = *(const LAS f32x4*)(TT + d8 + 4), tb0 = *(const LAS f32x4*)(TT + 128 + d8), tb1 = *(const LAS f32x4*)(TT + 128 + d8 + 4);
                        const bool fix = dir ? (c < 32) : (c >= 32);
                        float qd[8], ki[8], kd[8];
#pragma unroll
                        for (int j = 0; j < 8; ++j) { const float t0v = j < 4 ? ta0[j] : ta1[j - 4], t1v = j < 4 ? tb0[j] : tb1[j - 4]; const float bb = (j < 4 ? b0[j] : b1[j - 4]) + (fix ? (dir ? t1v : t0v) : 0.f);
                            const float e = __expf(bb); qd[j] = q[j] * 0.08838834764831845f * e; ki[j] = k[j] * __expf(-bb); kd[j] = k[j] * __expf((t0v + t1v) - bb); }
                        const bf16x8 qv = pack8(qd);
                        *(LAS bf16x8*)(lds + L_Q + c * 272 + d8 * 2) = qv; *(LAS bf16x8*)(lds + L_KI + c * 272 + d8 * 2) = pack8(ki); *(LAS bf16x8*)(lds + L_KD + c * 272 + d8 * 2) = pack8(kd);
                        *(bf16x8*)(GQ + ((tile0 + n) * 64 + c) * 128 + d8) = qv; }
#pragma unroll
                    for (int rep = 0; rep < 4; ++rep) { const int pidx = tid + 512 * rep, row = pidx >> 5, ch = pidx & 31; *(LAS bf16x8*)(lds + L_V + row * 528 + ch * 16) = n_pv[rep]; }
                    if (i8 + 1 < 8) cload(dir ? n - 1 : n + 1);
                    if (tid < 128) { const float dec = __expf(TT[tid] + TT[128 + tid]); DD[tid] = dec; GD[(tile0 + n) * 128 + tid] = dec; segp *= dec; }
                    lds_barrier();
                    if (wave < 4) { const int st = wave >> 1, ct = wave & 1; f32x16 x;
#pragma unroll
                        for (int q = 0; q < 16; ++q) x[q] = 0.f;
#pragma unroll
                        for (int ks = 0; ks < 8; ++ks) { const bf16x8 ak = *(const LAS bf16x8*)(lds + L_KI + (32 * st + r32) * 272 + (16 * ks + 8 * hh) * 2), bq = *(const LAS bf16x8*)(lds + L_Q + (32 * ct + r32) * 272 + (16 * ks + 8 * hh) * 2);
                            x = MFMA32(ak, bq, x); }
                        const int cpos = 32 * ct + r32;
#pragma unroll
                        for (int g = 0; g < 4; ++g) { float m4[4];
#pragma unroll
                            for (int j = 0; j < 4; ++j) { const int s = 32 * st + 8 * g + 4 * hh + j; const bool keep = dir ? (s >= cpos) : (s <= cpos); m4[j] = keep ? x[4 * g + j] : 0.f; }
                            u32x2 w; w.x = pk2(m4[0], m4[1]); w.y = pk2(m4[2], m4[3]); *(LAS u32x2*)(lds + L_P + cpos * 144 + (32 * st + 8 * g + 4 * hh) * 2) = w; } }
                    lds_barrier();
                    { f32x16 o[2];
#pragma unroll
                      for (int ct = 0; ct < 2; ++ct)
#pragma unroll
                          for (int j = 0; j < 16; ++j) o[ct][j] = 0.f;
#pragma unroll
                      for (int kk = 0; kk < 4; ++kk) { const unsigned va = ldsb + L_V + (16 * kk + 8 * hh + q4) * 528 + (32 * vs + 16 * blk + 4 * p4) * 2; const bf16x8 av = tr_read2(va, va + 4 * 528);
#pragma unroll
                          for (int ct = 0; ct < 2; ++ct) { const bf16x8 bp = *(const LAS bf16x8*)(lds + L_P + (32 * ct + r32) * 144 + (16 * kk + 8 * hh) * 2); o[ct] = MFMA32(av, bp, o[ct]); } }
#pragma unroll
                      for (int db = 0; db < 4; ++db)
#pragma unroll
                          for (int s = 0; s < 2; ++s) { const bf16x8 xs = pack_step(St[db], s);
#pragma unroll
                              for (int ct = 0; ct < 2; ++ct) { const LAS unsigned char* qp = lds + L_Q + (32 * ct + r32) * 272 + (32 * db + 16 * s + 4 * hh) * 2;
                                  const s16x4 lo4 = *(const LAS s16x4*)qp, hi4 = *(const LAS s16x4*)(qp + 16); const bf16x8 bq = __builtin_shufflevector(lo4, hi4, 0, 1, 2, 3, 4, 5, 6, 7);
                                  o[ct] = MFMA32(xs, bq, o[ct]); } }
#pragma unroll
                      for (int ct = 0; ct < 2; ++ct) { bf16_t* orow = OUT + (size_t)(t0 + 32 * ct + r32) * 1024 + h * 256 + 32 * vs + 4 * hh;
#pragma unroll
                          for (int g = 0; g < 4; ++g) { u32x2 w; w.x = pk2(o[ct][4 * g], o[ct][4 * g + 1]); w.y = pk2(o[ct][4 * g + 2], o[ct][4 * g + 3]); *(u32x2*)(orow + 8 * g) = w; } } }
#pragma unroll
                    for (int db = 0; db < 4; ++db) {
#pragma unroll
                        for (int g = 0; g < 4; ++g) { const f32x4 dv = *(const LAS f32x4*)(DD + 32 * db + 8 * g + 4 * hh);
#pragma unroll
                            for (int j = 0; j < 4; ++j) St[db][4 * g + j] *= dv[j]; } }
#pragma unroll
                    for (int kk = 0; kk < 4; ++kk) { bf16x8 bv, ak[4];
                        tr_scan10(ldsb + L_V + (16 * kk + 8 * hh + q4) * 528 + (32 * vs + 16 * blk + 4 * p4) * 2, ldsb + L_KD + (16 * kk + 8 * hh + q4) * 272 + (16 * blk + 4 * p4) * 2, bv, ak);
#pragma unroll
                        for (int db = 0; db < 4; ++db) St[db] = MFMA32(ak[db], bv, St[db]); }
                    lds_barrier();
                }
                float* fi = FIMG + ((size_t)(it * 8 + wave) * 64) * 64 + lane;
#pragma unroll
                for (int db = 0; db < 4; ++db)
#pragma unroll
                    for (int r = 0; r < 16; ++r) fi[(db * 16 + r) * 64] = St[db][r];
                if (tid < 128) SEGD[it * 128 + tid] = segp;
            }
            lds_barrier();
        }
        {
            constexpr int A_K = 0, A_V = 33792, A_SS = 67584;
            for (int it0 = bid; it0 < NB * (SEQ / 32) * ATT_REP; it0 += G) { const int it = it0 & 511;
                const int b = it >> 7, qb = it & 127, q0 = qb * 32; const int hq = wave, kvh = wave >> 2;
                const float slope = exp2f(-(float)(hq + 1)); const float sink = p.sink_logit[hq];
                bf16x8 qf[8];
#pragma unroll
                for (int s = 0; s < 8; ++s) qf[s] = *(const bf16x8*)(PROJ + (size_t)(b * SEQ + q0 + r32) * PLD + C_QA + hq * 128 + 16 * s + 8 * hh);
                f32x16 ot[4];
#pragma unroll
                for (int dt = 0; dt < 4; ++dt)
#pragma unroll
                    for (int i = 0; i < 16; ++i) ot[dt][i] = 0.f;
                float mrun = sink, lrun = 1.f; const int qpos = q0 + r32;
                int ktlo = 0, kthi = 4;
                while (q0 - 128 + 64 * ktlo + 63 < 0) ++ktlo;
                while (q0 - 128 + 64 * kthi >= SEQ) --kthi;
                bf16x8 pk_[4], pv_[4];
                auto kvload = [&](int kt) { const int k0 = q0 - 128 + 64 * kt;
#pragma unroll
                    for (int rep = 0; rep < 4; ++rep) { const int pidx = tid + 512 * rep, row = pidx >> 5, ch = pidx & 31; int kp = k0 + row; kp = kp < 0 ? 0 : (kp >= SEQ ? SEQ - 1 : kp);
                        const bf16_t* src = PROJ + (size_t)(b * SEQ + kp) * PLD; pk_[rep] = *(const bf16x8*)(src + C_KA + ch * 8); pv_[rep] = *(const bf16x8*)(src + C_VA + ch * 8); } };
                kvload(ktlo);
                for (int kt = ktlo; kt <= kthi; ++kt) {
                    const int k0 = q0 - 128 + 64 * kt;
                    lds_barrier();
#pragma unroll
                    for (int rep = 0; rep < 4; ++rep) { const int pidx = tid + 512 * rep, row = pidx >> 5, ch = pidx & 31;
                        *(LAS bf16x8*)(lds + A_K + row * 528 + ch * 16) = pk_[rep]; *(LAS bf16x8*)(lds + A_V + row * 528 + ch * 16) = pv_[rep]; }
                    lds_barrier();
                    if (kt < kthi) kvload(kt + 1);
                    f32x16 sc[2];
#pragma unroll
                    for (int kt2 = 0; kt2 < 2; ++kt2) {
#pragma unroll
                        for (int i = 0; i < 16; ++i) sc[kt2][i] = 0.f;
#pragma unroll
                        for (int s = 0; s < 8; ++s) { const bf16x8 ak = *(const LAS bf16x8*)(lds + A_K + (32 * kt2 + r32) * 528 + (kvh * 128 + 16 * s + 8 * hh) * 2); sc[kt2] = MFMA32(ak, qf[s], sc[kt2]); } }
                    float tmax = -3.0e38f; const float d0f = (float)(k0 - qpos + 4 * hh);
                    const bool edge = (kt == 0) || (kt == 4) || (k0 < 0) || (k0 + 64 > SEQ);
#pragma unroll
                    for (int kt2 = 0; kt2 < 2; ++kt2)
#pragma unroll
                        for (int i = 0; i < 16; ++i) { const float rf = d0f + (float)(32 * kt2 + (i & 3) + 8 * (i >> 2)); float v = sc[kt2][i] * 0.08838834764831845f - slope * fabsf(rf);
                            if (edge) { const float kp = rf + (float)qpos; v = (fabsf(rf) <= 128.f && kp >= 0.f && kp < (float)SEQ) ? v : -3.0e38f; }
                            sc[kt2][i] = v; tmax = fmaxf(tmax, v); }
                    tmax = fmaxf(tmax, __shfl_xor(tmax, 32));
                    const float mnew = fmaxf(mrun, tmax), alpha = __expf(mrun - mnew); float ps = 0.f;
#pragma unroll
                    for (int kt2 = 0; kt2 < 2; ++kt2)
#pragma unroll
                        for (int i = 0; i < 16; ++i) { const float pv = __expf(sc[kt2][i] - mnew); sc[kt2][i] = pv; ps += pv; }
                    ps += __shfl_xor(ps, 32);
                    lrun = lrun * alpha + ps; mrun = mnew;
#pragma unroll
                    for (int dt = 0; dt < 4; ++dt)
#pragma unroll
                        for (int i = 0; i < 16; ++i) ot[dt][i] *= alpha;
#pragma unroll
                    for (int kk = 0; kk < 4; ++kk) { const bf16x8 bp = pack_step(sc[kk >> 1], kk & 1); bf16x8 av[4];
                        tr8<64, 4224>(ldsb + A_V + (16 * kk + 4 * hh + q4) * 528 + (kvh * 128 + 16 * blk + 4 * p4) * 2, av);
#pragma unroll
                        for (int dt = 0; dt < 4; ++dt) ot[dt] = MFMA32(av[dt], bp, ot[dt]); }
                }
                const float linv = 1.f / lrun; float ss = 0.f;
#pragma unroll
                for (int dt = 0; dt < 4; ++dt)
#pragma unroll
                    for (int i = 0; i < 16; ++i) { ot[dt][i] *= linv; ss += ot[dt][i] * ot[dt][i]; }
                ss += __shfl_xor(ss, 32);
                LAS float* SS = (LAS float*)(lds + A_SS);
                lds_barrier();
                if (hh == 0) SS[hq * 32 + r32] = ss;
                lds_barrier();
                float tot = 0.f;
#pragma unroll
                for (int w8 = 0; w8 < 8; ++w8) tot += SS[w8 * 32 + r32];
                const float rstd = rsqrtf(tot * (1.f / 1024.f) + EPS);
                bf16_t* orow = A2 + (size_t)(b * SEQ + q0 + r32) * DM + hq * 128 + 4 * hh; const float* gn = p.attn_out_norm + hq * 128 + 4 * hh;
#pragma unroll
                for (int dt = 0; dt < 4; ++dt)
#pragma unroll
                    for (int g = 0; g < 4; ++g) { const f32x4 gg = *(const f32x4*)(gn + 32 * dt + 8 * g); u32x2 w;
                        w.x = pk2(ot[dt][4 * g] * rstd * gg[0], ot[dt][4 * g + 1] * rstd * gg[1]); w.y = pk2(ot[dt][4 * g + 2] * rstd * gg[2], ot[dt][4 * g + 3] * rstd * gg[3]);
                        *(u32x2*)(orow + 32 * dt + 8 * g) = w; }
            }
            lds_barrier();
        }
        { SchedPre S{G, bid, (const char*)MEMK, (const char*)MEMV, (const char*)WCQ, (const char*)WCO, (char*)WQK, (char*)WVO};
          pg8::EpiStore8 E{p.norm_cross, 0.04419417382415922f * WQK_SCALE, WVO_SCALE};
          pg8::gemm_phase<pg8::EpiStore8, SchedPre, true>(lds, DM * 2, 8, S, E, wave); }
#ifndef DBG
        xcd_barrier(xbar, wave);
#else
    }
    if (lo == 13) { PH_IDS
#endif
        {
            const int lane = lane_id_v(), tid = wave * 64 + lane, r32 = lane & 31, hh = lane >> 5;
            constexpr int XS_ = 17920;
            static_assert(8 * XS_ <= MISC_OFF, "X3 LDS");
            for (int dry = X3_DRY; dry >= 0; --dry)
            for (int it = bid; it < 256; it += G) {
                const int dir = it & 1, h = (it >> 1) & 3, b = (it >> 3) & 3, sg = it >> 5; const int vs = wave;
                if (sg == 0) continue;
                const size_t tile0 = (size_t)((b * 4 + h) * 2 + dir) * 64; bf16_t* OUT = dir ? O3 : O2;
                lds_barrier();
#pragma unroll
                for (int c8 = 0; c8 < 8; ++c8) { const int i = 8 * sg + c8; const int n = dir ? 63 - i : i; const bf16_t* q = GQ + (tile0 + n) * 8192;
#pragma unroll
                    for (int rep = 0; rep < 2; ++rep) { const int pidx = tid + 512 * rep, row = pidx >> 4, ch = pidx & 15; *(LAS bf16x8*)(lds + c8 * XS_ + row * 272 + ch * 16) = *(const bf16x8*)(q + pidx * 8); }
                    if (tid < 32) *(LAS f32x4*)(lds + c8 * XS_ + 17408 + tid * 16) = *(const f32x4*)(GD + (tile0 + n) * 128 + tid * 4); }
                f32x16 St[4];
#pragma unroll
                for (int db = 0; db < 4; ++db)
#pragma unroll
                    for (int i = 0; i < 16; ++i) St[db][i] = 0.f;
                for (int i = 0; i < sg; ++i) { const int iti = (i << 5) | (it & 31); const float* fi = FIMG + ((size_t)(iti * 8 + wave) * 64) * 64 + lane; const float* sd = SEGD + iti * 128 + 4 * hh;
                    f32x16 fv[4];
#pragma unroll
                    for (int db = 0; db < 4; ++db)
#pragma unroll
                        for (int r = 0; r < 16; ++r) fv[db][r] = fi[(db * 16 + r) * 64];
#pragma unroll
                    for (int db = 0; db < 4; ++db)
#pragma unroll
                        for (int g = 0; g < 4; ++g) { const f32x4 dv = *(const f32x4*)(sd + 32 * db + 8 * g);
#pragma unroll
                            for (int j = 0; j < 4; ++j) St[db][4 * g + j] = St[db][4 * g + j] * dv[j] + fv[db][4 * g + j]; } }
                lds_barrier();
                u32x2 oldv[2][4];
                { const int n0_ = dir ? 63 - 8 * sg : 8 * sg;
#pragma unroll
                  for (int ct = 0; ct < 2; ++ct) { const bf16_t* orow = OUT + (size_t)(b * SEQ + n0_ * 64 + 32 * ct + r32) * 1024 + h * 256 + 32 * vs + 4 * hh;
#pragma unroll
                      for (int g = 0; g < 4; ++g) oldv[ct][g] = *(const u32x2*)(orow + 8 * g); } }
                for (int c8 = 0; c8 < 8; ++c8) { const int i = 8 * sg + c8; const int n = dir ? 63 - i : i; LAS unsigned char* sb = lds + c8 * XS_;
                    f32x16 o[2];
#pragma unroll
                    for (int ct = 0; ct < 2; ++ct)
#pragma unroll
                        for (int j = 0; j < 16; ++j) o[ct][j] = 0.f;
                    u32x2 nxtv[2][4];
                    { const int nn = dir ? n - 1 : n + 1;
#pragma unroll
                      for (int ct = 0; ct < 2; ++ct) { const bf16_t* orow = OUT + (size_t)(b * SEQ + (c8 < 7 ? nn : n) * 64 + 32 * ct + r32) * 1024 + h * 256 + 32 * vs + 4 * hh;
#pragma unroll
                          for (int g = 0; g < 4; ++g) nxtv[ct][g] = *(const u32x2*)(orow + 8 * g); } }
#pragma unroll
                    for (int db = 0; db < 4; ++db)
#pragma unroll
                        for (int s = 0; s < 2; ++s) { const bf16x8 xs = pack_step(St[db], s);
#pragma unroll
                            for (int ct = 0; ct < 2; ++ct) { const LAS unsigned char* qp = sb + (32 * ct + r32) * 272 + (32 * db + 16 * s + 4 * hh) * 2;
                                const s16x4 lo4 = *(const LAS s16x4*)qp, hi4 = *(const LAS s16x4*)(qp + 16); const bf16x8 bq = __builtin_shufflevector(lo4, hi4, 0, 1, 2, 3, 4, 5, 6, 7);
                                o[ct] = MFMA32(xs, bq, o[ct]); } }
#pragma unroll
                    for (int ct = 0; ct < 2; ++ct) { bf16_t* orow = OUT + (size_t)(b * SEQ + n * 64 + 32 * ct + r32) * 1024 + h * 256 + 32 * vs + 4 * hh;
#pragma unroll
                        for (int g = 0; g < 4; ++g) { const u32x2 old = oldv[ct][g]; u32x2 w;
                            w.x = pk2(o[ct][4 * g] + bflo(old.x), o[ct][4 * g + 1] + bfhi(old.x)); w.y = pk2(o[ct][4 * g + 2] + bflo(old.y), o[ct][4 * g + 3] + bfhi(old.y)); if (!dry || w.x == 0x12345678u) *(u32x2*)(orow + 8 * g) = w; oldv[ct][g] = nxtv[ct][g]; } }
#pragma unroll
                    for (int db = 0; db < 4; ++db) {
#pragma unroll
                        for (int g = 0; g < 4; ++g) { const f32x4 dv = *(const LAS f32x4*)(sb + 17408 + (32 * db + 8 * g + 4 * hh) * 4);
#pragma unroll
                            for (int j = 0; j < 4; ++j) St[db][4 * g + j] *= dv[j]; } }
                }
            }
            lds_barrier();
        }
    }
    SEAM(3);

    if (IN(4)) for (int rp_ = 0; rp_ < (RPT == 4 ? 2 : 1); ++rp_) { PH_IDS
        {
            bf16x8 c0[6], n0[6];
            auto ld = [&](int t, bf16x8 (&d)[6]) { const size_t o = (size_t)t * 1024 + lane * 16; const size_t ro = (size_t)t * PLD + C_RG + lane * 16;
                d[0] = *(const bf16x8*)(O2 + o); d[1] = *(const bf16x8*)(O2 + o + 8);
                d[2] = *(const bf16x8*)(O3 + o); d[3] = *(const bf16x8*)(O3 + o + 8); d[4] = *(const bf16x8*)(PROJ + ro); d[5] = *(const bf16x8*)(PROJ + ro + 8); };
            const float* gn = p.gla_out_norm + (lane & 15) * 16; float gnv[16];
#pragma unroll
            for (int j = 0; j < 16; ++j) gnv[j] = gn[j];
            if (gw < NT) ld(gw, c0);
            for (int t = gw; t < NT; t += NGW) {
                const int tn = t + NGW; ld(tn < NT ? tn : t, n0);
                float v[16], a[8], r[16];
                unpack8(c0[0], v); unpack8(c0[1], v + 8);
                unpack8(c0[2], a);
#pragma unroll
                for (int j = 0; j < 8; ++j) v[j] += a[j];
                unpack8(c0[3], a);
#pragma unroll
                for (int j = 0; j < 8; ++j) v[8 + j] += a[j];
                unpack8(c0[4], r); unpack8(c0[5], r + 8);
                float ss = 0.f;
#pragma unroll
                for (int j = 0; j < 16; ++j) ss += v[j] * v[j];
                ss += __shfl_xor(ss, 1); ss += __shfl_xor(ss, 2); ss += __shfl_xor(ss, 4); ss += __shfl_xor(ss, 8);
                const float rstd = rsqrtf(ss * (1.f / 256.f) + EPS); float w[16];
#pragma unroll
                for (int j = 0; j < 16; ++j) { const float rr = r[j]; w[j] = v[j] * rstd * gnv[j] * (rr / (1.f + __expf(-rr))); }
                *(bf16x8*)(A2 + (size_t)t * DM + 1024 + lane * 16) = pack8(w); *(bf16x8*)(A2 + (size_t)t * DM + 1024 + lane * 16 + 8) = pack8(w + 8);
#pragma unroll
                for (int j = 0; j < 6; ++j) c0[j] = n0[j];
            }
        }
    }
    SEAM(4);

    if (IN(5)) for (int rp_ = 0; rp_ < (RPT == 5 ? 2 : 1); ++rp_) { PH_IDS
        SchedTok S{G, bid, 8, (const char*)A2, (const char*)WOUT, (size_t)256 * DM * 2, (size_t)256 * DM * 2, 0};
        pg8::EpiRes1 E{p.x, H1B, H1F8, SSQ};
        pg8::gemm_phase<pg8::EpiRes1, SchedTok, true>(lds, DM * 2, DM / 64, S, E, wave);
    }
    SEAM(5);

    if (IN(6)) for (int rp_ = 0; rp_ < (RPT == 6 ? 2 : 1); ++rp_) { PH_IDS
        SchedTok S{G, bid, 4, (const char*)H1F8, (const char*)WQK, (size_t)256 * DM, (size_t)256 * DM, (size_t)1024 * DM};
        pg8::EpiSoftmax E{SSQ, PB};
        for (int i = 0;; ++i) { SchedOne S1; if (!S.next(i, S1.u0)) break; pg8::gemm_phase<pg8::EpiSoftmax, SchedOne, false, true>(lds, DM, DM / 128, S1, E, wave); }
    }
    SEAM(6);

    if (IN(7)) for (int rp_ = 0; rp_ < (RPT == 7 ? 2 : 1); ++rp_) { PH_IDS
        SchedTok S{G, bid, 8, (const char*)PB, (const char*)WVO, (size_t)256 * 1024, (size_t)256 * 1024, (size_t)2048 * 1024};
#if P7_DRY
        { pg8::EpiRes2<false> E0{H1B, (bf16_t*)(ws + 707 * MiB), nullptr, nullptr}; pg8::gemm_phase<pg8::EpiRes2<false>, SchedTok, true, true>(lds, 1024, 1024 / 128, S, E0, wave); }
#endif
        pg8::EpiRes2<true> E{H1B, H1B, HN8, p.norm_ffn};
        pg8::gemm_phase<pg8::EpiRes2<true>, SchedTok, true, true>(lds, 1024, 1024 / 128, S, E, wave);
    }
    SEAM(7);

    if (IN(8)) for (int rp_ = 0; rp_ < (RPT == 8 ? 2 : 1); ++rp_) { PH_IDS
        LAS float* LG = (LAS float*)(lds + (wave & 3) * 4096);
        LAS float* PT = (LAS float*)(lds + 16384 + (wave & 3) * 4096);
        for (int tile0 = 0; tile0 < NT / 16; tile0 += 4 * G) {
            const int tile = tile0 + (wave & 3) * G + bid; const bool act = tile < NT / 16; const int kh = wave >> 2;
            const int t0 = (act ? tile : 0) * 16, i16 = lane & 15, kq = lane >> 4;
            const bf16_t* xr = H1B + (size_t)(t0 + i16) * DM + 4 * kq + 1024 * kh; f32x4 acc[3]; float ss = 0.f;
#pragma unroll
            for (int c = 0; c < 3; ++c) acc[c] = (f32x4){0.f, 0.f, 0.f, 0.f};
            if (act) {
#pragma unroll 8
            for (int kb = 0; kb < 64; ++kb) { const u32x2 ab = *(const u32x2*)(xr + 16 * kb); const f32x4 a = {bflo(ab.x), bfhi(ab.x), bflo(ab.y), bfhi(ab.y)}; ss += (a[0] * a[0] + a[1] * a[1]) + (a[2] * a[2] + a[3] * a[3]);
#pragma unroll
                for (int c = 0; c < 3; ++c) { const f32x4 bw = ((const f32x4*)WR)[((64 * kh + kb) * 3 + c) * 64 + lane];
#pragma unroll
                    for (int e = 0; e < 4; ++e) acc[c] = __builtin_amdgcn_mfma_f32_16x16x4f32(a[e], bw[e], acc[c], 0, 0, 0); } }
            }
            if (kh == 1) {
#pragma unroll
                for (int c = 0; c < 3; ++c) *(LAS f32x4*)(PT + (c * 64 + lane) * 4) = acc[c];
                PT[768 + lane] = ss; }
            __syncthreads();
            if (kh == 0) {
#pragma unroll
                for (int c = 0; c < 3; ++c) acc[c] = acc[c] + *(const LAS f32x4*)(PT + (c * 64 + lane) * 4);
                ss += PT[768 + lane];
                ss += __shfl_xor(ss, 16); ss += __shfl_xor(ss, 32);
                const float rstd = rsqrtf(ss * (1.f / DM) + EPS);
#pragma unroll
                for (int c = 0; c < 3; ++c)
#pragma unroll
                    for (int r = 0; r < 4; ++r) LG[(4 * kq + r) * 48 + 16 * c + i16] = acc[c][r];
                if (kq == 0) LG[768 + i16] = rstd;
            }
            asm volatile("s_waitcnt lgkmcnt(0)" ::: "memory");
            if (kh == 0 && act)
            if (lane < 16) { const int t = t0 + lane; const float rs = LG[768 + lane]; const LAS float* l = LG + lane * 48;
                float g[4]; int gi = 0;
#pragma unroll
                for (int j = 0; j < 4; ++j) g[j] = l[j] * rs + p.b_rg[j];
                float gm = g[0];
#pragma unroll
                for (int j = 1; j < 4; ++j) if (g[j] > gm) { gm = g[j]; gi = j; }
                float gs = 0.f;
#pragma unroll
                for (int j = 0; j < 4; ++j) gs += __expf(g[j] - gm);
                const float pg = 1.f / gs;
                float e1 = -3.0e38f, e2 = -3.0e38f; int i1 = 0, i2 = 0;
                for (int j = 0; j < 8; ++j) { const float v = l[4 + gi * 8 + j] * rs + p.b_re[gi * 8 + j]; if (v > e1) { e2 = e1; i2 = i1; e1 = v; i1 = j; } else if (v > e2) { e2 = v; i2 = j; } }
                const float w2 = __expf(e2 - e1); const float g1 = pg / (1.f + w2), g2 = pg * w2 / (1.f + w2);
                const int ea = gi * 8 + i1, eb = gi * 8 + i2;
                const int sa = (int)atomicAdd(CNT + ea, 1u), sb2 = (int)atomicAdd(CNT + eb, 1u);
                LIST[ea * 16384 + sa] = t; LIST[eb * 16384 + sb2] = t;
                ASG_E[2 * t] = ea; ASG_E[2 * t + 1] = eb; ASG_S[2 * t] = sa; ASG_S[2 * t + 1] = sb2; ASG_G[2 * t] = g1; ASG_G[2 * t + 1] = g2; RSTD3[t] = rs; }
            __syncthreads();
        }
    }
    SEAM(8);

    if (IN(9)) for (int rp_ = 0; rp_ < (RPT == 9 ? 2 : 1); ++rp_) { PH_IDS }

    if (IN(10)) for (int rp_ = 0; rp_ < (RPT == 10 ? 2 : 1); ++rp_) { PH_IDS
        moe_table(CNT, TBL, tid);
        LAS float* RSB = (LAS float*)(lds + MISC_OFF + 4608);
        SchedMoe S{TBL, LIST, RSTD3, RSB, G, bid, __builtin_amdgcn_readfirstlane(TBL[0]), TBL + 64, (const char*)HN8, (const char*)WGU, (char*)HID, (size_t)0, (size_t)2048 * DM, (size_t)256 * DM, (size_t)256 * DFF, 128, DFF, MOE1_REP};
        pg8::EpiHid E{RSB};
        pg8::gemm_phase<pg8::EpiHid, SchedMoe, true, true, true>(lds, DM, DM / 128, S, E, wave);
        __syncthreads();
    }
    SEAM(10);

    if (IN(11)) for (int rp_ = 0; rp_ < (RPT == 11 ? 2 : 1); ++rp_) { PH_IDS
        moe_table(CNT, TBL, tid);
        SchedMoe S{TBL, nullptr, nullptr, nullptr, G, bid, __builtin_amdgcn_readfirstlane(TBL[0]), TBL + 64, (const char*)HID, (const char*)WD, (char*)YS, (size_t)256 * DFF, (size_t)2048 * DFF, (size_t)256 * DFF, (size_t)256 * DM, 256, DM, MOE2_REP};
        pg8::EpiStore8 E{nullptr, 0.f, YS_SCALE / (W_SCALE * HID_SCALE)};
        pg8::gemm_phase<pg8::EpiStore8, SchedMoe, true, true>(lds, DFF, DFF / 128, S, E, wave);
        __syncthreads();
    }
    SEAM(11);

    if (IN(12)) for (int rp_ = 0; rp_ < (RPT == 12 ? 2 : 1); ++rp_) { PH_IDS
        moe_table(CNT, TBL, tid);
        const f32x4* grf = (const f32x4*)p.norm_final + lane; f32x4 gfin[8];
#pragma unroll
        for (int j = 0; j < 8; ++j) gfin[j] = grf[64 * j];
        for (int base = 0; base < NT; base += 8 * NGW) {
        int mda[8], mdb[8]; float mga[8], mgb[8];
#pragma unroll
        for (int q = 0; q < 8; ++q) { const int t = base + gw + q * NGW; const int tt = t < NT ? t : 0; mda[q] = TBL[1 + ASG_E[2 * tt]] * 256 + ASG_S[2 * tt]; mdb[q] = TBL[1 + ASG_E[2 * tt + 1]] * 256 + ASG_S[2 * tt + 1]; mga[q] = ASG_G[2 * tt]; mgb[q] = ASG_G[2 * tt + 1]; }
        for (int dry = P12_DRY; dry >= 0; --dry)
#pragma unroll
        for (int q = 0; q < 8; ++q) { const int t = base + gw + q * NGW; if (t >= NT) break;
            const int da = mda[q], db = mdb[q]; const float ga = mga[q] * (1.f / YS_SCALE), gb = mgb[q] * (1.f / YS_SCALE);
            f32x4* xr = (f32x4*)(H + (size_t)t * DM) + lane; const u32x2* hr = (const u32x2*)(H1B + (size_t)t * DM) + lane; const unsigned* ya = (const unsigned*)(YS + (size_t)da * DM) + lane; const unsigned* yb = (const unsigned*)(YS + (size_t)db * DM) + lane;
            f32x4 v[8]; float s = 0.f;
#pragma unroll
            for (int j = 0; j < 8; ++j) { const u32x2 hb = hr[64 * j]; v[j] = (f32x4){bflo(hb.x), bfhi(hb.x), bflo(hb.y), bfhi(hb.y)}; const unsigned a = ya[64 * j], b2 = yb[64 * j];
                v[j][0] += ga * __builtin_amdgcn_cvt_f32_fp8((int)a, 0) + gb * __builtin_amdgcn_cvt_f32_fp8((int)b2, 0); v[j][1] += ga * __builtin_amdgcn_cvt_f32_fp8((int)a, 1) + gb * __builtin_amdgcn_cvt_f32_fp8((int)b2, 1);
                v[j][2] += ga * __builtin_amdgcn_cvt_f32_fp8((int)a, 2) + gb * __builtin_amdgcn_cvt_f32_fp8((int)b2, 2); v[j][3] += ga * __builtin_amdgcn_cvt_f32_fp8((int)a, 3) + gb * __builtin_amdgcn_cvt_f32_fp8((int)b2, 3);
                s += (v[j][0] * v[j][0] + v[j][1] * v[j][1]) + (v[j][2] * v[j][2] + v[j][3] * v[j][3]); }
            const float rstd = rsqrtf(wave_sum(s) * (1.f / DM) + EPS);
#pragma unroll
            for (int j = 0; j < 8; ++j) { const f32x4 g = gfin[j]; f32x4 o; o[0] = v[j][0] * rstd * g[0]; o[1] = v[j][1] * rstd * g[1]; o[2] = v[j][2] * rstd * g[2]; o[3] = v[j][3] * rstd * g[3]; (dry ? ((f32x4*)(ws + 555 * MiB) + (size_t)t * 512 + lane) : xr)[64 * j] = o; }
        }
        }
    }
    for (int xb_ = 0; xb_ < XBAR_EXTRA; ++xb_) xcd_barrier(xbar, wave);
#undef IN
#undef SEAM
}


#undef WGU
#undef WD
#undef WIN
#undef WCKV
#undef WOUT
#undef WCO
#undef WCQ
#undef WQK
#undef WVO
#undef U
#undef H1B
#undef H1F8
#undef HN8
#undef LIST
#undef MEMN
#undef MEMK
#undef MEMV
#undef PROJ
#undef PB
#undef GQ
#undef GK
#undef GD
#undef O1
#undef O2
#undef O3
#undef A2
#undef SSQ
#undef XS
#undef HID
#undef YS
#undef WR
#undef FIMG
#undef SEGD
#undef ASG_E
#undef ASG_S
#undef ASG_G
#undef RSTD3
#undef DEST
#undef CNT
#ifdef DBG
__device__ __forceinline__ unsigned hsh(unsigned x) { x ^= x >> 16; x *= 0x7feb352dU; x ^= x >> 15; x *= 0x846ca68bU; x ^= x >> 16; return x; }
__device__ __forceinline__ float bfr(float f) { unsigned w = pk2(f, 0.f); return bflo(w); }
__device__ __forceinline__ void rec(unsigned* errs, int slot, float got, float want, float atol) {
    float e = fabsf(got - want) / (fabsf(want) + atol); if (!(e == e)) e = 1.0e9f; if (!(got == got)) e = 1.0e9f;
    atomicMax(errs + slot, __float_as_uint(e));
}
__device__ __forceinline__ void rec8(unsigned* errs, int slot, float got, float want, float atol) { rec(errs, slot, want + 0.4f * (got - want), want, atol); }
__device__ __forceinline__ float wdot8(const unsigned char* a, const unsigned char* b, int K, int lane) { float s = 0.f; for (int k = lane; k < K; k += 64) s += fp8f(a[k]) * fp8f(b[k]); return wave_sum(s); }
__device__ __forceinline__ float wdot(const bf16_t* a, const bf16_t* b, int K, int lane) { float s = 0.f; for (int k = lane; k < K; k += 64) s += bf2f(a[k]) * bf2f(b[k]); return wave_sum(s); }
__device__ __forceinline__ float lsig16(float pre) { return (fminf(pre, 0.f) - logf(1.f + expf(-fabsf(pre)))) * (1.f / 16.f); }
__device__ __forceinline__ float gate_at(const Params& p, const bf16_t* PROJ, int row, int h, int d, int dir) {
    const float* wg = dir ? p.w_gla_gb : p.w_gla_gf; float pre = (dir ? p.b_gla_gb : p.b_gla_gf)[h * 128 + d];
    for (int r = 0; r < 16; ++r) pre += bf2f(PROJ[(size_t)row * PLD + C_LRF + 16 * dir + r]) * wg[r * 512 + h * 128 + d];
    return lsig16(pre);
}
__global__ void __launch_bounds__(256) chk_kernel(Params p, int stage, unsigned* errs) {
    __shared__ float sh[4][1536];
    const int lane = threadIdx.x & 63, wv = threadIdx.x >> 6, gwv = blockIdx.x * 4 + wv, NW = gridDim.x * 4;
    unsigned char* ws = p.ws;
    unsigned char* WGU = (unsigned char*)(ws + WS_WGU); unsigned char* WD = (unsigned char*)(ws + WS_WD); bf16_t* WIN = (bf16_t*)(ws + WS_WIN); bf16_t* WCKV = (bf16_t*)(ws + WS_WCKV);
    bf16_t* WOUT = (bf16_t*)(ws + WS_WOUT); bf16_t* WCO = (bf16_t*)(ws + WS_WCO); bf16_t* WCQ = (bf16_t*)(ws + WS_WCQ);
    unsigned char* WQK = (unsigned char*)(ws + WS_WQK); unsigned char* WVO = (unsigned char*)(ws + WS_WVO); unsigned char* H1F8 = (unsigned char*)(ws + WS_H1F8);
    bf16_t* U = (bf16_t*)(ws + WS_U); bf16_t* H1B = (bf16_t*)(ws + WS_H1B); bf16_t* MEMN = (bf16_t*)(ws + WS_MEMN); bf16_t* MEMK = (bf16_t*)(ws + WS_MEMK); bf16_t* MEMV = (bf16_t*)(ws + WS_MEMV);
    bf16_t* PROJ = (bf16_t*)(ws + WS_PROJ); unsigned char* PB = (unsigned char*)(ws + WS_P); bf16_t* GQ = (bf16_t*)(ws + WS_GQ); bf16_t* GK = (bf16_t*)(ws + WS_GK); float* GD = (float*)(ws + WS_GD);
    bf16_t* O1 = (bf16_t*)(ws + WS_O1); bf16_t* O2 = (bf16_t*)(ws + WS_O2); bf16_t* O3 = (bf16_t*)(ws + WS_O3); bf16_t* A2 = (bf16_t*)(ws + WS_A2);
    float* SSQ = (float*)(ws + WS_SSQ); unsigned char* XS = (unsigned char*)(ws + WS_XS); unsigned char* HID = (unsigned char*)(ws + WS_HID); unsigned char* YS = (unsigned char*)(ws + WS_YS);
    float* WR = (float*)(ws + WS_WR);
    int* ASG_E = (int*)(ws + WS_ASG); int* ASG_S = ASG_E + 2 * NT; float* ASG_G = (float*)(ASG_S + 2 * NT); float* RSTD3 = ASG_G + 2 * NT; int* DEST = (int*)(RSTD3 + NT);
    unsigned* CNT = (unsigned*)(ws + WS_CTL) + CW_CNT;
    float* H = p.out; float* shw = sh[wv];
    const int NS = 16;
    for (int si = 0; si < NS; ++si) {
        const unsigned r0 = hsh((unsigned)(gwv * NS + si) * 2654435761u + (unsigned)stage * 97u + 12345u), r1 = hsh(r0 + 1u), r2 = hsh(r0 + 2u), r3 = hsh(r0 + 3u);
        if (stage == 0) {
            const unsigned q0 = hsh(r0 + lane * 7919u), q1 = hsh(q0 + 1u), q2 = hsh(q0 + 2u);
            { const int n = q0 % 4864, k = q1 % 2048; const float want = n < 4640 ? bfr(p.w_in[(size_t)k * 4640 + n]) : 0.f; rec(errs, 0 * 4 + 0, bf2f(WIN[(size_t)n * DM + k]), want, 1e-4f); }
            { const int n = q0 % 2048, k = q1 % 2048;
              rec(errs, 0 * 4 + 0, bf2f(WCKV[(size_t)n * DM + k]), bfr(p.w_ck[(size_t)k * DM + n]), 1e-4f); rec(errs, 0 * 4 + 0, bf2f(WCKV[(size_t)(2048 + n) * DM + k]), bfr(p.w_cv[(size_t)k * DM + n]), 1e-4f); }
            { const int t = r1 % NT; float s = 0.f; for (int k = lane; k < DM; k += 64) { const float v = p.x[(size_t)t * DM + k]; s += v * v; } const float rs = rsqrtf(wave_sum(s) / DM + EPS);
              const int k = q0 % DM; rec(errs, 0 * 4 + 0, bf2f(U[(size_t)t * DM + k]), p.x[(size_t)t * DM + k] * rs * p.norm_mix[k], 1e-2f); }
            { const int t = r1 % 1024; float s = 0.f; for (int k = lane; k < DM; k += 64) { const float v = p.mem[(size_t)t * DM + k]; s += v * v; } const float rs = rsqrtf(wave_sum(s) / DM + EPS);
              const int k = q0 % DM; rec(errs, 0 * 4 + 0, bf2f(MEMN[(size_t)t * DM + k]), p.mem[(size_t)t * DM + k] * rs * p.norm_mem[k], 1e-2f); }
        } else if (stage == 1) {
            { const unsigned q0 = hsh(r0 + lane * 7919u), q1 = hsh(q0 + 1u), q2 = hsh(q0 + 2u);
              { const int n = q0 % 2048, k = q1 % 2048; rec(errs, 1 * 4 + 3, bf2f(WOUT[(size_t)n * DM + k]), bfr(p.w_out[(size_t)k * DM + n]), 1e-4f);
                rec(errs, 1 * 4 + 3, bf2f(WCO[(size_t)n * DM + k]), bfr(p.w_co[(size_t)k * DM + n]), 1e-4f); rec(errs, 1 * 4 + 3, bf2f(WCQ[(size_t)n * DM + k]), bfr(p.w_cq[(size_t)n * DM + k]), 1e-4f); }
            { const int e = q2 % 32, k = q1 % 2048, j = q0 % 1024; rec8(errs, 1 * 4 + 2, fp8f(WGU[((size_t)e * 2048 + (j >> 7) * 256 + (j & 127)) * DM + k]), W_SCALE * p.w_gate[((size_t)e * DM + k) * DFF + j], 2e-2f);
              rec8(errs, 1 * 4 + 2, fp8f(WGU[((size_t)e * 2048 + (j >> 7) * 256 + 128 + (j & 127)) * DM + k]), W_SCALE * p.w_up[((size_t)e * DM + k) * DFF + j], 2e-2f);
              const int n = q0 % 2048, kk = q1 % 1024; rec8(errs, 1 * 4 + 2, fp8f(WD[((size_t)e * 2048 + n) * DFF + kk]), W_SCALE * p.w_down[((size_t)e * DFF + kk) * DM + n], 2e-2f); }
            }
            { const int t = r0 % NT, n = r1 % 4864; const float want = wdot(U + (size_t)t * DM, WIN + (size_t)n * DM, DM, lane); if (lane == 0) rec(errs, 1 * 4 + 0, bf2f(PROJ[(size_t)t * PLD + n]), want, 1.0f); }
            { const int t = r2 % 1024, n = r3 % 4096; const float want = wdot(MEMN + (size_t)t * DM, WCKV + (size_t)n * DM, DM, lane);
              if (lane == 0) rec(errs, 1 * 4 + 1, bf2f((n < 2048 ? MEMK : MEMV)[(size_t)t * DM + (n & 2047)]), want, 1.0f); }
        } else if (stage == 2) {
        } else if (stage == 3) {
            if (si < 2) {
                const int b = r0 & 3, h = (r0 >> 2) & 3, dir = (r0 >> 4) & 1, tpos = r1 % SEQ, v = r2 & 255; const int row = b * SEQ + tpos;
                float E0 = 0.f, E1 = 0.f, acc = 0.f; const float q0 = bf2f(PROJ[(size_t)row * PLD + C_QG + h * 128 + lane]) * 0.08838834764831845f, q1 = bf2f(PROJ[(size_t)row * PLD + C_QG + h * 128 + lane + 64]) * 0.08838834764831845f;
                for (int st_ = 0; st_ < 768; ++st_) { const int s = dir ? tpos + st_ : tpos - st_; if (s < 0 || s >= SEQ) break; const int srow = b * SEQ + s;
                    float a = q0 * expf(E0) * bf2f(PROJ[(size_t)srow * PLD + C_KG + h * 128 + lane]) + q1 * expf(E1) * bf2f(PROJ[(size_t)srow * PLD + C_KG + h * 128 + lane + 64]);
                    a = wave_sum(a); acc += a * bf2f(PROJ[(size_t)srow * PLD + C_VG + h * 256 + v]);
                    if (dir == 0) { E0 += gate_at(p, PROJ, srow, h, lane, 0); E1 += gate_at(p, PROJ, srow, h, lane + 64, 0); }
                    else { E0 += gate_at(p, PROJ, srow, h, lane, 1); E1 += gate_at(p, PROJ, srow, h, lane + 64, 1); } }
                if (lane == 0) rec(errs, 3 * 4 + 0, bf2f((dir ? O3 : O2)[(size_t)row * 1024 + h * 256 + v]), acc, 2.0f);
            } else if (si < 8) {
                const int b = r0 & 3, tpos = r1 % SEQ; const int row = b * SEQ + tpos; float* pr = shw; float* oh = shw + 320; float tot = 0.f;
                for (int hq = 0; hq < 8; ++hq) { const int kvh = hq >> 2; const float slope = exp2f(-(float)(hq + 1)); float mx = p.sink_logit[hq];
                    for (int j = lane; j < 257; j += 64) { const int kp = tpos - 128 + j; float sc = -3.0e38f;
                        if (kp >= 0 && kp < SEQ) { float s = 0.f; for (int d = 0; d < 128; ++d) s += bf2f(PROJ[(size_t)row * PLD + C_QA + hq * 128 + d]) * bf2f(PROJ[(size_t)(b * SEQ + kp) * PLD + C_KA + kvh * 128 + d]);
                            sc = s * 0.08838834764831845f - slope * fabsf((float)(kp - tpos)); }
                        pr[j] = sc; mx = fmaxf(mx, sc); }
                    for (int o = 1; o < 64; o <<= 1) mx = fmaxf(mx, __shfl_xor(mx, o));
                    float sm = 0.f; for (int j = lane; j < 257; j += 64) { const float e = pr[j] > -1.0e38f ? expf(pr[j] - mx) : 0.f; pr[j] = e; sm += e; }
                    sm = wave_sum(sm) + expf(p.sink_logit[hq] - mx);
                    __builtin_amdgcn_s_waitcnt(0);
                    for (int dd = 0; dd < 2; ++dd) { const int d = lane + 64 * dd; float o = 0.f;
                        for (int j = 0; j < 257; ++j) { const int kp = tpos - 128 + j; if (kp >= 0 && kp < SEQ) o += pr[j] * bf2f(PROJ[(size_t)(b * SEQ + kp) * PLD + C_VA + kvh * 128 + d]); }
                        o /= sm; oh[hq * 128 + d] = o; tot += o * o; }
                    __builtin_amdgcn_s_waitcnt(0); }
                tot = wave_sum(tot); const float rs = rsqrtf(tot / 1024.f + EPS);
                for (int i = lane; i < 1024; i += 64) rec(errs, 3 * 4 + 1, bf2f(A2[(size_t)row * DM + i]), oh[i] * rs * p.attn_out_norm[i], 1.0f);
            } else {
                const int b = r0 & 3, h = (r0 >> 2) & 3, m = r1 & 255, c = r2 & 2047;
                float s = 0.f; for (int d = lane; d < 512; d += 64) s += bf2f(MEMK[(size_t)(b * 256 + m) * DM + h * 512 + d]) * bf2f(WCQ[(size_t)c * DM + h * 512 + d]); s = wave_sum(s) * p.norm_cross[c] * 0.04419417382415922f;
                if (lane == 0) rec8(errs, 3 * 4 + 2, fp8f(WQK[((size_t)b * 1024 + h * 256 + m) * DM + c]) / WQK_SCALE, s, 0.02f);
                s = 0.f; for (int d = lane; d < 512; d += 64) s += bf2f(MEMV[(size_t)(b * 256 + m) * DM + h * 512 + d]) * bf2f(WCO[(size_t)c * DM + h * 512 + d]); s = wave_sum(s);
                if (lane == 0) rec8(errs, 3 * 4 + 3, fp8f(WVO[((size_t)b * 2048 + c) * 1024 + h * 256 + m]) / WVO_SCALE, s, 0.5f);
            }
        } else if (stage == 4) {
            const int t = r0 % NT;
            for (int hh = 0; hh < 4; ++hh) { float vv[4]; float ss = 0.f;
_Pragma("unroll")
                for (int j = 0; j < 4; ++j) { const size_t o = (size_t)t * 1024 + hh * 256 + lane + 64 * j; vv[j] = bf2f(O2[o]) + bf2f(O3[o]); ss += vv[j] * vv[j]; }
                ss = wave_sum(ss); const float rs = rsqrtf(ss / 256.f + EPS);
_Pragma("unroll")
                for (int j = 0; j < 4; ++j) { const int v = lane + 64 * j; const float r = bf2f(PROJ[(size_t)t * PLD + C_RG + hh * 256 + v]);
                    rec(errs, 4 * 4 + 0, bf2f(A2[(size_t)t * DM + 1024 + hh * 256 + v]), vv[j] * rs * p.gla_out_norm[v] * (r / (1.f + expf(-r))), 0.5f); } }
        } else if (stage == 5) {
            const int t = r0 % NT, n = r1 % DM; const float want = p.x[(size_t)t * DM + n] + wdot(A2 + (size_t)t * DM, WOUT + (size_t)n * DM, DM, lane);
            if (lane == 0) { rec(errs, 5 * 4 + 1, bf2f(H1B[(size_t)t * DM + n]), want, 1.0f); }
            float s = 0.f; for (int k = lane; k < DM; k += 64) { const float v = bf2f(H1B[(size_t)t * DM + k]); s += v * v; } s = wave_sum(s);
            float q = lane < 32 ? SSQ[(size_t)t * 32 + lane] : 0.f; q = wave_sum(q); if (lane == 0) rec(errs, 5 * 4 + 2, q, s, 1.0f);
        } else if (stage == 6) {
            const int t = r0 % NT, h = r1 & 3, b = t / SEQ; float s = 0.f; for (int k = lane; k < DM; k += 64) { const float v = bf2f(H1B[(size_t)t * DM + k]); s += v * v; } const float rs = rsqrtf(wave_sum(s) / DM + EPS);
            float sc[4]; float mx = -3.0e38f;
_Pragma("unroll")
            for (int j = 0; j < 4; ++j) { const int m = lane + 64 * j; float a = 0.f; for (int k = 0; k < DM; ++k) a += fp8f(H1F8[(size_t)t * DM + k]) * fp8f(WQK[((size_t)b * 1024 + h * 256 + m) * DM + k]); sc[j] = a * rs / WQK_SCALE; mx = fmaxf(mx, sc[j]); }
            for (int o = 1; o < 64; o <<= 1) mx = fmaxf(mx, __shfl_xor(mx, o));
            float sm = 0.f;
_Pragma("unroll")
            for (int j = 0; j < 4; ++j) { sc[j] = expf(sc[j] - mx); sm += sc[j]; } sm = wave_sum(sm);
_Pragma("unroll")
            for (int j = 0; j < 4; ++j) rec8(errs, 6 * 4 + 0, fp8f(PB[(size_t)t * 1024 + h * 256 + lane + 64 * j]) / P_SCALE, sc[j] / sm, 4e-3f);
        } else if (stage == 7) {
            const int t = r0 % NT, n = r1 % DM, b = t / SEQ; const float want = bf2f(H1B[(size_t)t * DM + n]) + 0.f * wdot8(PB + (size_t)t * 1024, WVO + ((size_t)b * 2048 + n) * 1024, 1024, lane);
            if (lane == 0) rec(errs, 7 * 4 + 0, bf2f(H1B[(size_t)t * DM + n]), want, 0.3f);
        } else if (stage == 8) {
            const int t = r0 % NT; double s = 0.0; for (int k = lane; k < DM; k += 64) { const double v = bf2f(H1B[(size_t)t * DM + k]); s += v * v; }
            for (int o = 1; o < 64; o <<= 1) s += __shfl_xor(s, o);
            const double rs = 1.0 / sqrt(s / DM + 1e-6); float* lg = shw;
            for (int j = 0; j < 36; ++j) { double a = 0.0; for (int k = lane; k < DM; k += 64) { const double w = j < 4 ? p.w_rg[k * 4 + j] : p.w_re[k * 32 + j - 4]; a += (double)bf2f(H1B[(size_t)t * DM + k]) * rs * p.norm_ffn[k] * w; }
                for (int o = 1; o < 64; o <<= 1) a += __shfl_xor(a, o); if (lane == 0) lg[j] = (float)(a + (j < 4 ? p.b_rg[j] : p.b_re[j - 4])); }
            __builtin_amdgcn_s_waitcnt(0);
            if (lane == 0) { int gi = 0; for (int j = 1; j < 4; ++j) if (lg[j] > lg[gi]) gi = j; float gs = 0; for (int j = 0; j < 4; ++j) gs += expf(lg[j] - lg[gi]); const float pg = 1.f / gs;
                int i1 = 0; for (int j = 1; j < 8; ++j) if (lg[4 + gi * 8 + j] > lg[4 + gi * 8 + i1]) i1 = j; int i2 = -1; for (int j = 0; j < 8; ++j) if (j != i1 && (i2 < 0 || lg[4 + gi * 8 + j] > lg[4 + gi * 8 + i2])) i2 = j;
                const float w2 = expf(lg[4 + gi * 8 + i2] - lg[4 + gi * 8 + i1]);
                rec(errs, 8 * 4 + 0, (float)(ASG_E[2 * t] != gi * 8 + i1), 0.f, 1e-6f); rec(errs, 8 * 4 + 0, (float)(ASG_E[2 * t + 1] != gi * 8 + i2), 0.f, 1e-6f);
                rec(errs, 8 * 4 + 1, ASG_G[2 * t], pg / (1 + w2), 1e-3f); rec(errs, 8 * 4 + 1, ASG_G[2 * t + 1], pg * w2 / (1 + w2), 1e-3f); rec(errs, 8 * 4 + 2, RSTD3[t], (float)rs, 1e-6f);
                const int sa = ASG_S[2 * t], sb = ASG_S[2 * t + 1]; if (sa < 0 || sa >= (int)CNT[ASG_E[2 * t]] || sb < 0 || sb >= (int)CNT[ASG_E[2 * t + 1]]) rec(errs, 8 * 4 + 3, 1.f, 0.f, 1e-6f); }
            __builtin_amdgcn_s_waitcnt(0);
        } else if (stage == 9 || stage == 10 || stage == 11) {
            const int t = r0 % NT, kk = r1 & 1; const int e = ASG_E[2 * t + kk]; int pst = 0; for (int j = 0; j < e; ++j) pst += ((int)CNT[j] + 255) >> 8; const int dst = pst * 256 + ASG_S[2 * t + kk];
            if (stage == 9) { }
            else if (stage == 10) { const int j = r2 % 1024; const unsigned char* HN8c = (const unsigned char*)(ws + WS_H1F8); const float g = wdot8(HN8c + (size_t)t * DM, WGU + ((size_t)e * 2048 + (j >> 7) * 256 + (j & 127)) * DM, DM, lane) * RSTD3[t] / W_SCALE, u = wdot8(HN8c + (size_t)t * DM, WGU + ((size_t)e * 2048 + (j >> 7) * 256 + 128 + (j & 127)) * DM, DM, lane) * RSTD3[t] / W_SCALE;
                if (lane == 0) rec8(errs, 10 * 4 + 0, fp8f(HID[(size_t)dst * DFF + j]) / HID_SCALE, g / (1.f + expf(-g)) * u, 0.5f); }
            else { const int n = r2 % DM; const float y = wdot8(HID + (size_t)dst * DFF, WD + ((size_t)e * 2048 + n) * DFF, DFF, lane) / (W_SCALE * HID_SCALE); if (lane == 0) rec8(errs, 11 * 4 + 0, fp8f(YS[(size_t)dst * DM + n]) / YS_SCALE, y, 0.6f); }
        }
    }
}
__global__ void apply_kernel(float* out, const unsigned* errs, int n) {
    int code = 0;
    for (int s = 51; s >= 0; --s) if (__uint_as_float(errs[s]) > DBG_THR) code = s + 1;
    if (code == 0) return;
    for (int i = blockIdx.x * blockDim.x + threadIdx.x; i < n; i += gridDim.x * blockDim.x) out[i] *= (float)(1 + code);
}
#endif
extern "C" void kernel_launch(void* const* d_in, const int* in_sizes, int n_in, void* d_out, int out_size, void* d_ws, size_t ws_size, hipStream_t stream) {
    static int grid = 0;
    if (grid == 0) {
        if (n_in != 27 || out_size != NT * DM || ws_size < WS_END) { fprintf(stderr, "kernel_launch: unexpected problem: n_in %d out %d ws %zu (need %zu)\n", n_in, out_size, ws_size, (size_t)WS_END); grid = -1; return; }
        int dev = 0, cus = 0, per_cu = 0;
        if (hipGetDevice(&dev) != hipSuccess || hipDeviceGetAttribute(&cus, hipDeviceAttributeMultiprocessorCount, dev) != hipSuccess) { grid = -1; return; }
        if (hipFuncSetAttribute((const void*)fwd_mega, hipFuncAttributeMaxDynamicSharedMemorySize, LDS_BYTES) != hipSuccess) { fprintf(stderr, "kernel_launch: hipFuncSetAttribute failed\n"); grid = -1; return; }
        if (hipOccupancyMaxActiveBlocksPerMultiprocessor(&per_cu, (const void*)fwd_mega, 512, LDS_BYTES) != hipSuccess || per_cu < 1) { fprintf(stderr, "kernel_launch: occupancy query says %d blocks per CU\n", per_cu); grid = -1; (void)hipGetLastError(); return; }
        grid = cus;
    }
    if (grid < 0) return;
    (void)hipMemsetAsync((char*)d_ws + WS_CTL, 0, 32768, stream);
    Params p{};
    const float** pf = (const float**)&p;
    for (int i = 0; i < 27; ++i) pf[i] = (const float*)d_in[i];
    p.out = (float*)d_out; p.ws = (unsigned char*)d_ws; p.ph_lo = 0; p.ph_hi = 13;

#ifdef DBG
    unsigned* errs = (unsigned*)((char*)d_ws + WS_CTL) + 1024;
    for (int ph = 0; ph < 13; ++ph) {
        p.ph_lo = ph; p.ph_hi = ph + 1;
        void* a2[] = {&p};
        (void)a2; hipLaunchKernelGGL(fwd_mega, dim3(grid), dim3(512), LDS_BYTES, stream, p);
        if (ph == 3) { p.ph_lo = 13; p.ph_hi = 14; hipLaunchKernelGGL(fwd_mega, dim3(grid), dim3(512), LDS_BYTES, stream, p); }
        if (ph < 12) hipLaunchKernelGGL(chk_kernel, dim3(64), dim3(256), 0, stream, p, ph, errs);
    }
    hipLaunchKernelGGL(apply_kernel, dim3(1024), dim3(256), 0, stream, (float*)d_out, errs, NT * DM);
    return;
#endif
    void* args[] = {&p};
    (void)args;
    hipLaunchKernelGGL(fwd_mega, dim3(grid), dim3(512), LDS_BYTES, stream, p);
    hipError_t e = hipPeekAtLastError();
    if (e != hipSuccess) fprintf(stderr, "kernel_launch: launch failed: %s (grid %d)\n", hipGetErrorString(e), grid);
}
```

```cpp
#define DBG_THR 0.06f
#ifndef SCAN_REP
#define SCAN_REP 1
#define ATT_REP 1
#define MOE1_REP 1
#define MOE2_REP 1
#endif
#ifndef P7_DRY
#define P7_DRY 0
#define P12_DRY 0
#define P0E_REP 0
#define XBAR_EXTRA 0
#define P0E_NOSTORE 0
#define X3_DRY 0
#define PRE_REP 1
#define P0T_REP 1
#define P0R_REP 1
#endif
#ifndef RPT
#define RPT -1
#endif
#include <hip/hip_runtime.h>
#include <hip/hip_cooperative_groups.h>
#include <cstdio>
#include <cstdint>
namespace cg = cooperative_groups;

#define LAS __attribute__((address_space(3)))
typedef unsigned short bf16_t;
typedef short bf16x8 __attribute__((ext_vector_type(8)));
typedef short s16x4 __attribute__((ext_vector_type(4)));
typedef float f32x2 __attribute__((ext_vector_type(2)));
typedef float f32x4 __attribute__((ext_vector_type(4)));
typedef float f32x16 __attribute__((ext_vector_type(16)));
typedef unsigned u32x2 __attribute__((ext_vector_type(2)));
typedef unsigned u32x4 __attribute__((ext_vector_type(4)));
typedef __bf16 bf16v2 __attribute__((ext_vector_type(2)));
typedef int i32x8 __attribute__((ext_vector_type(8)));
typedef int i32x4 __attribute__((ext_vector_type(4)));

constexpr int DM = 2048, NB = 4, SEQ = 4096, NT = NB * SEQ;
constexpr int PLD = 4864;
constexpr int C_QA = 0, C_KA = 1024, C_VA = 1280, C_QG = 1536, C_KG = 2048, C_VG = 2560, C_RG = 3584, C_LRF = 4608, C_LRB = 4624;
constexpr int NEXP = 32, DFF = 1024, MEML = 256;
constexpr int RMAX = NT * 2 + NEXP * 256;
constexpr float EPS = 1e-6f;
constexpr float WQK_SCALE = 64.f, WVO_SCALE = 8.f, P_SCALE = 256.f;
constexpr float W_SCALE = 64.f, HID_SCALE = 8.f, YS_SCALE = 16.f;

constexpr size_t MiB = 1u << 20;
constexpr size_t WS_CTL = 0;
constexpr size_t WS_WR = 1 * MiB;
constexpr size_t WS_ASG = 1 * MiB + 512 * 1024;
constexpr size_t WS_GD = 2 * MiB + 512 * 1024;
constexpr size_t WS_WGU = 4 * MiB;
constexpr size_t WS_WD = 260 * MiB;
constexpr size_t WS_WIN = 388 * MiB;
constexpr size_t WS_WCKV = 407 * MiB;
constexpr size_t WS_WOUT = 423 * MiB;
constexpr size_t WS_WCO = 431 * MiB;
constexpr size_t WS_WCQ = 439 * MiB;
constexpr size_t WS_WQK = 447 * MiB;
constexpr size_t WS_WVO = 463 * MiB;
constexpr size_t WS_U = 479 * MiB;
constexpr size_t WS_H1B = 479 * MiB;
constexpr size_t WS_MEMN = 543 * MiB;
constexpr size_t WS_MEMK = 547 * MiB;
constexpr size_t WS_MEMV = 551 * MiB;
constexpr size_t WS_PROJ = 555 * MiB;
constexpr size_t WS_P = 555 * MiB;
constexpr size_t WS_GQ = 707 * MiB;
constexpr size_t WS_GK = 739 * MiB;
constexpr size_t WS_O1 = 771 * MiB;
constexpr size_t WS_O2 = 803 * MiB;
constexpr size_t WS_O3 = 835 * MiB;
constexpr size_t WS_A2 = 867 * MiB;
constexpr size_t WS_H1F8 = 771 * MiB;
constexpr size_t WS_SSQ = 931 * MiB;
constexpr size_t WS_XS = 555 * MiB;
constexpr size_t WS_HID = 715 * MiB;
constexpr size_t WS_YS = 795 * MiB;
constexpr size_t WS_FIMG = 955 * MiB;
constexpr size_t WS_SEGD = 987 * MiB;
constexpr size_t WS_END = 988 * MiB;
constexpr int CW_CNT = 0;
constexpr int CW_BAR = 4096;

constexpr int LDS_BYTES = 155648;
constexpr int MISC_OFF = 147456;

__device__ __forceinline__ unsigned pk2(float lo, float hi) { f32x2 v = {lo, hi}; bf16v2 b = __builtin_convertvector(v, bf16v2); return __builtin_bit_cast(unsigned, b); }
__device__ __forceinline__ float clamp8(float v) { return fminf(fmaxf(v, -448.f), 448.f); }
__device__ __forceinline__ unsigned pk4_fp8(float a, float b, float c, float d) { int w = 0; w = __builtin_amdgcn_cvt_pk_fp8_f32(clamp8(a), clamp8(b), w, false); w = __builtin_amdgcn_cvt_pk_fp8_f32(clamp8(c), clamp8(d), w, true); return (unsigned)w; }
__device__ __forceinline__ float fp8f(unsigned char x) { return __builtin_amdgcn_cvt_f32_fp8((int)x, 0); }
__device__ __forceinline__ float bf2f(unsigned short x) { return __uint_as_float(((unsigned)x) << 16); }
__device__ __forceinline__ float bflo(unsigned w) { return __uint_as_float(w << 16); }
__device__ __forceinline__ float bfhi(unsigned w) { return __uint_as_float(w & 0xffff0000u); }
__device__ __forceinline__ float wave_sum(float v) {
#pragma unroll
    for (int o = 1; o < 64; o <<= 1) v += __shfl_xor(v, o);
    return v;
}
__device__ __forceinline__ bf16x8 pack8(const float* v) { u32x4 p; p.x = pk2(v[0], v[1]); p.y = pk2(v[2], v[3]); p.z = pk2(v[4], v[5]); p.w = pk2(v[6], v[7]); return __builtin_bit_cast(bf16x8, p); }
__device__ __forceinline__ void unpack8(bf16x8 b, float* v) { u32x4 p = __builtin_bit_cast(u32x4, b); v[0] = bflo(p.x); v[1] = bfhi(p.x); v[2] = bflo(p.y); v[3] = bfhi(p.y); v[4] = bflo(p.z); v[5] = bfhi(p.z); v[6] = bflo(p.w); v[7] = bfhi(p.w); }
__device__ __forceinline__ int lane_id_v() { int l; asm volatile("v_mbcnt_lo_u32_b32 %0, -1, 0\n\tv_mbcnt_hi_u32_b32 %0, -1, %0" : "=v"(l)); return l & 63; }
__device__ __forceinline__ int crow(int r, int hi) { return (r & 3) + 8 * (r >> 2) + 4 * hi; }
__device__ __forceinline__ bf16x8 pack_step(const f32x16& x, int s) {
    u32x4 p; p.x = pk2(x[8 * s], x[8 * s + 1]); p.y = pk2(x[8 * s + 2], x[8 * s + 3]); p.z = pk2(x[8 * s + 4], x[8 * s + 5]); p.w = pk2(x[8 * s + 6], x[8 * s + 7]);
    return __builtin_bit_cast(bf16x8, p);
}
__device__ __forceinline__ bf16x8 tr_read2(unsigned a0, unsigned a1) {
    s16x4 lo, hi;
    asm volatile("ds_read_b64_tr_b16 %0, %2\n\tds_read_b64_tr_b16 %1, %3\n\ts_waitcnt lgkmcnt(0)" : "=&v"(lo), "=&v"(hi) : "v"(a0), "v"(a1) : "memory");
    return __builtin_shufflevector(lo, hi, 0, 1, 2, 3, 4, 5, 6, 7);
}

template <int OA, int OB>
__device__ __forceinline__ void tr8(unsigned a, bf16x8 (&f)[4]) {
    s16x4 r0, r1, r2, r3, r4, r5, r6, r7;
    asm volatile("ds_read_b64_tr_b16 %0, %8\n\tds_read_b64_tr_b16 %1, %8 offset:%9\n\tds_read_b64_tr_b16 %2, %8 offset:%10\n\tds_read_b64_tr_b16 %3, %8 offset:%11\n\t"
                 "ds_read_b64_tr_b16 %4, %8 offset:%12\n\tds_read_b64_tr_b16 %5, %8 offset:%13\n\tds_read_b64_tr_b16 %6, %8 offset:%14\n\tds_read_b64_tr_b16 %7, %8 offset:%15\n\ts_waitcnt lgkmcnt(0)"
                 : "=&v"(r0), "=&v"(r1), "=&v"(r2), "=&v"(r3), "=&v"(r4), "=&v"(r5), "=&v"(r6), "=&v"(r7)
                 : "v"(a), "i"(OB), "i"(OA), "i"(OA + OB), "i"(2 * OA), "i"(2 * OA + OB), "i"(3 * OA), "i"(3 * OA + OB) : "memory");
    f[0] = __builtin_shufflevector(r0, r1, 0, 1, 2, 3, 4, 5, 6, 7); f[1] = __builtin_shufflevector(r2, r3, 0, 1, 2, 3, 4, 5, 6, 7);
    f[2] = __builtin_shufflevector(r4, r5, 0, 1, 2, 3, 4, 5, 6, 7); f[3] = __builtin_shufflevector(r6, r7, 0, 1, 2, 3, 4, 5, 6, 7);
}
__device__ __forceinline__ void tr_scan10(unsigned va, unsigned ka, bf16x8& bv, bf16x8 (&ak)[4]) {
    s16x4 v0, v1, r0, r1, r2, r3, r4, r5, r6, r7;
    asm volatile("ds_read_b64_tr_b16 %0, %10\n\tds_read_b64_tr_b16 %1, %10 offset:2112\n\t"
                 "ds_read_b64_tr_b16 %2, %11\n\tds_read_b64_tr_b16 %3, %11 offset:1088\n\tds_read_b64_tr_b16 %4, %11 offset:64\n\tds_read_b64_tr_b16 %5, %11 offset:1152\n\t"
                 "ds_read_b64_tr_b16 %6, %11 offset:128\n\tds_read_b64_tr_b16 %7, %11 offset:1216\n\tds_read_b64_tr_b16 %8, %11 offset:192\n\tds_read_b64_tr_b16 %9, %11 offset:1280\n\ts_waitcnt lgkmcnt(0)"
                 : "=&v"(v0), "=&v"(v1), "=&v"(r0), "=&v"(r1), "=&v"(r2), "=&v"(r3), "=&v"(r4), "=&v"(r5), "=&v"(r6), "=&v"(r7) : "v"(va), "v"(ka) : "memory");
    bv = __builtin_shufflevector(v0, v1, 0, 1, 2, 3, 4, 5, 6, 7);
    ak[0] = __builtin_shufflevector(r0, r1, 0, 1, 2, 3, 4, 5, 6, 7); ak[1] = __builtin_shufflevector(r2, r3, 0, 1, 2, 3, 4, 5, 6, 7);
    ak[2] = __builtin_shufflevector(r4, r5, 0, 1, 2, 3, 4, 5, 6, 7); ak[3] = __builtin_shufflevector(r6, r7, 0, 1, 2, 3, 4, 5, 6, 7);
}
__device__ __forceinline__ void lds_barrier() { asm volatile("s_waitcnt lgkmcnt(0)" ::: "memory"); __builtin_amdgcn_s_barrier(); asm volatile("" ::: "memory"); }
#define MFMA32(a, b, c) __builtin_amdgcn_mfma_f32_32x32x16_bf16((a), (b), (c), 0, 0, 0)

namespace pg8 {
constexpr int BM = 256, BK = 64, HALF = 128, HTB = HALF * BK * 2, STAGE_BYTES = 8 * HTB, NXCD = 8, WGM = 8;
__host__ __device__ __forceinline__ int lds_byte(int r, int c) { const int st = (r >> 4) * 2 + (c >> 5), rr = r & 15, cc = c & 31, ob = rr * 64 + cc * 2; return st * 1024 + (ob ^ (((ob >> 9) & 1) << 5)); }
__host__ __device__ __forceinline__ void stage_rc(int b, int& R, int& C) { const int st = b / 1024, sb = b % 1024, swz = sb ^ (((sb >> 9) & 1) << 5); R = (st >> 1) * 16 + swz / 64; C = (st & 1) * 32 + (swz % 64) / 2; }
__host__ __device__ __forceinline__ int perm32(int rho) { const int n = rho >> 4, i = rho & 15; return 8 * (i >> 2) + 4 * n + (i & 3); }

struct Unit { const char* a; const char* b; char* o; int pm, pn, ldo, z; };

__device__ __forceinline__ void tile_map(int L, int nM, int nN, int& pm, int& pn) {
    const int nwg = nM * nN; int wgid = L;
    { const int q = nwg / NXCD, r = nwg % NXCD, xcd = wgid % NXCD, off = wgid / NXCD; wgid = (xcd < r ? xcd * (q + 1) : r * (q + 1) + (xcd - r) * q) + off; }
    const int nig = WGM * nN, gid = wgid / nig, fm = gid * WGM, gsz = (nM - fm) < WGM ? (nM - fm) : WGM;
    pm = fm + ((wgid % nig) % gsz); pn = (wgid % nig) / gsz;
}

template <class Epi, class Sched, bool ALIGN_EPI, bool FP8 = false, bool GATHER = false>
__device__ __forceinline__ void gemm_phase(LAS unsigned char* lds, const int ldb  , const int nt_arg  , const Sched& S, const Epi& E, const int wid) {
    int nt = nt_arg; asm volatile("" : "+s"(nt));
    const int lane = lane_id_v(), tid = wid * 64 + lane, wr = wid >> 2, wc = wid & 3, fr = lane & 15, fq = lane >> 4;
    unsigned voffA[2], voffB[2];
#pragma unroll
    for (int i = 0; i < 2; ++i) { int R, C; stage_rc(tid * 16 + i * 8192, R, C); const int Rb = (R & ~31) + perm32(R & 31);
        voffA[i] = (unsigned)(R * ldb + C * 2); voffB[i] = (unsigned)(Rb * ldb + C * 2); }
    const size_t kstep = (size_t)(BK * 2);
    const size_t hstep = (size_t)HALF * ldb;
    const unsigned ldsw = (unsigned)wid * 1024u;
    const int aoff = lds_byte(wr * 64 + fr, fq * 8), boff = lds_byte(wc * 32 + fr, fq * 8);
#define PG8_SA(b, h) (((b) * 2 + (h)) * HTB)
#define PG8_SB(b, h) ((4 + (b) * 2 + (h)) * HTB)
#define PG8_STAGE(bufoff, gbase, voff) do { _Pragma("unroll") for (int _i = 0; _i < 2; ++_i) \
        __builtin_amdgcn_global_load_lds((const unsigned*)((const char*)(gbase) + (voff)[_i]), (LAS unsigned*)(lds + (bufoff) + ldsw + _i * 8192), 16, 0, 0); } while (0)
#define PG8_GOFF(slot, half) (LAS u32x2*)(lds + 131072 + ((((slot) & 1) * 2 + (half)) * 512 + tid) * 8)
#define PG8_STAGE_A(bufoff, gbase, half, usenext) do { if constexpr (GATHER) { const u32x2 _go = *PG8_GOFF(ui + ((usenext) ? 1 : 0), half); _Pragma("unroll") for (int _i = 0; _i < 2; ++_i) \
        __builtin_amdgcn_global_load_lds((const unsigned*)((const char*)(gbase) + _go[_i]), (LAS unsigned*)(lds + (bufoff) + ldsw + _i * 8192), 16, 0, 0); } \
        else { PG8_STAGE(bufoff, (const char*)(gbase) + (half) * hstep, voffA); } } while (0)
#define PG8_LDA(dst, b, h) do { _Pragma("unroll") for (int m = 0; m < 4; ++m) { if constexpr (FP8) dst##8[m] = __builtin_shufflevector(*(const LAS i32x4*)(lds + PG8_SA(b, h) + aoff + m * 2048), *(const LAS i32x4*)(lds + PG8_SA(b, h) + aoff + m * 2048 + 1024), 0, 1, 2, 3, 4, 5, 6, 7); \
        else { _Pragma("unroll") for (int k = 0; k < 2; ++k) dst[m][k] = *(const LAS bf16x8*)(lds + PG8_SA(b, h) + aoff + m * 2048 + k * 1024); } } } while (0)
#define PG8_LDB(dst, b, h) do { _Pragma("unroll") for (int n = 0; n < 2; ++n) { if constexpr (FP8) dst##8[n] = __builtin_shufflevector(*(const LAS i32x4*)(lds + PG8_SB(b, h) + boff + n * 2048), *(const LAS i32x4*)(lds + PG8_SB(b, h) + boff + n * 2048 + 1024), 0, 1, 2, 3, 4, 5, 6, 7); \
        else { _Pragma("unroll") for (int k = 0; k < 2; ++k) dst[n][k] = *(const LAS bf16x8*)(lds + PG8_SB(b, h) + boff + n * 2048 + k * 1024); } } } while (0)
#define PG8_MMA(ai, bj, At, Bt) do { __builtin_amdgcn_s_setprio(1); _Pragma("unroll") for (int m = 0; m < 4; ++m) _Pragma("unroll") for (int n = 0; n < 2; ++n) { \
        if constexpr (FP8) { asm volatile("v_mfma_scale_f32_16x16x128_f8f6f4 %0, %1, %2, %0, %3, %3 op_sel_hi:[0,0,0]" : "+v"(acc[ai][bj][m][n]) : "v"(Bt##8[n]), "v"(At##8[m]), "v"(sc1)); } \
        else { _Pragma("unroll") for (int k = 0; k < 2; ++k) acc[ai][bj][m][n] = __builtin_amdgcn_mfma_f32_16x16x32_bf16(Bt[n][k], At[m][k], acc[ai][bj][m][n], 0, 0, 0); } } \
        __builtin_amdgcn_s_setprio(0); } while (0)
#define PG8_WAIT_V(n) asm volatile("s_waitcnt vmcnt(" #n ")" ::: "memory")
#define PG8_WAIT_L(n) asm volatile("s_waitcnt lgkmcnt(" #n ")" ::: "memory")
#define PG8_BAR __builtin_amdgcn_s_barrier()
#define PG8_SCHED __builtin_amdgcn_sched_barrier(0)
    Unit cur, nxt; int ui = 0;
    if (!S.next(0, cur)) return;
    f32x4 acc[2][2][4][2];
#pragma unroll
    for (int a = 0; a < 2; ++a)
#pragma unroll
        for (int b = 0; b < 2; ++b)
#pragma unroll
            for (int m = 0; m < 4; ++m)
#pragma unroll
                for (int n = 0; n < 2; ++n) acc[a][b][m][n] = (f32x4){0.f, 0.f, 0.f, 0.f};
    int sc1 = 0x7f7f7f7f; asm volatile("" : "+v"(sc1));
    bf16x8 At[4][2], B0[2][2], B1[2][2]; i32x8 At8[4], B08[2], B18[2]; (void)At; (void)B0; (void)B1; (void)At8; (void)B08; (void)B18;
    const char* cA = cur.a; const char* cB = cur.b;
    if constexpr (GATHER) { S.rs_fill(cur, tid);
#pragma unroll
        for (int hf = 0; hf < 2; ++hf) { u32x2 go;
#pragma unroll
            for (int i = 0; i < 2; ++i) { int R, C; stage_rc(tid * 16 + i * 8192, R, C); go[i] = (unsigned)S.rowtok(cur, hf * HALF + R) * (unsigned)ldb + (unsigned)(C * 2); }
            *PG8_GOFF(0, hf) = go; } }
    PG8_STAGE(PG8_SB(0, 0), cB, voffB); PG8_STAGE(PG8_SB(0, 1), cB + hstep, voffB); PG8_STAGE_A(PG8_SA(0, 0), cA, 0, false); PG8_STAGE_A(PG8_SA(0, 1), cA, 1, false);
    if (wr == 1) PG8_BAR;
    PG8_WAIT_V(2); PG8_BAR;
    PG8_STAGE(PG8_SB(1, 0), cB + kstep, voffB); PG8_STAGE_A(PG8_SA(1, 0), cA + kstep, 0, false); PG8_STAGE(PG8_SB(1, 1), cB + hstep + kstep, voffB);
    PG8_WAIT_V(6); PG8_BAR;
    for (;;) {
        const bool has_next = S.next(ui + 1, nxt);
        const char* nA = has_next ? nxt.a : cA; const char* nB = has_next ? nxt.b : cB;
        if constexpr (GATHER) { if (has_next) S.rs_fill(nxt, tid);
#pragma unroll
            for (int hf = 0; hf < 2; ++hf) { u32x2 go;
                if (has_next) {
#pragma unroll
                    for (int i = 0; i < 2; ++i) { int R, C; stage_rc(tid * 16 + i * 8192, R, C); go[i] = (unsigned)S.rowtok(nxt, hf * HALF + R) * (unsigned)ldb + (unsigned)(C * 2); } }
                else go = *PG8_GOFF(ui, hf);
                *PG8_GOFF(ui + 1, hf) = go; } }
#pragma unroll 1
        for (int t = 0; t < nt; t += 2) {
            const bool last = (t == nt - 2);
            const char* a1 = cA + (size_t)(t + 1) * kstep;
            const char* a2 = last ? nA : cA + (size_t)(t + 2) * kstep; const char* b2 = last ? nB : cB + (size_t)(t + 2) * kstep;
            const char* a3 = a2 + kstep; const char* b3 = b2 + kstep;
            PG8_LDB(B0, 0, 0); PG8_LDB(B1, 0, 1); PG8_SCHED; PG8_LDA(At, 0, 0); PG8_STAGE_A(PG8_SA(1, 1), a1, 1, false);
            PG8_WAIT_V(8); PG8_WAIT_L(0); PG8_BAR; PG8_MMA(0, 0, At, B0); PG8_MMA(0, 1, At, B1); PG8_BAR; PG8_SCHED;
            PG8_LDA(At, 0, 1); PG8_STAGE(PG8_SB(0, 0), b2, voffB); PG8_STAGE(PG8_SB(0, 1), b2 + hstep, voffB); PG8_STAGE_A(PG8_SA(0, 0), a2, 0, last);
            PG8_WAIT_V(8); PG8_WAIT_L(0); PG8_BAR; PG8_MMA(1, 0, At, B0); PG8_MMA(1, 1, At, B1); PG8_BAR; PG8_SCHED;
            PG8_LDB(B0, 1, 0); PG8_LDB(B1, 1, 1); PG8_SCHED; PG8_LDA(At, 1, 0); PG8_STAGE_A(PG8_SA(0, 1), a2, 1, last);
            PG8_WAIT_V(8); PG8_WAIT_L(0); PG8_BAR; PG8_MMA(0, 0, At, B0); PG8_MMA(0, 1, At, B1); PG8_BAR; PG8_SCHED;
            PG8_LDA(At, 1, 1); PG8_STAGE(PG8_SB(1, 0), b3, voffB); PG8_STAGE(PG8_SB(1, 1), b3 + hstep, voffB); PG8_STAGE_A(PG8_SA(1, 0), a3, 0, last);
            PG8_WAIT_V(8); PG8_WAIT_L(0); PG8_BAR; PG8_MMA(1, 0, At, B0); PG8_MMA(1, 1, At, B1); PG8_BAR; PG8_SCHED;
        }
        if constexpr (ALIGN_EPI) { if (wr == 0) PG8_BAR; }
        if constexpr (FP8) asm volatile("s_nop 15\n\ts_nop 15" ::: "memory");
        if constexpr (!Epi::AFTER_DRAIN) { E(acc, cur, wr, wc, fr, fq); }
        if (!has_next) break;
#pragma unroll
        for (int a = 0; a < 2; ++a)
#pragma unroll
            for (int b = 0; b < 2; ++b)
#pragma unroll
                for (int m = 0; m < 4; ++m)
#pragma unroll
                    for (int n = 0; n < 2; ++n) acc[a][b][m][n] = (f32x4){0.f, 0.f, 0.f, 0.f};
        cur = nxt; cA = nA; cB = nB; ++ui;
        if constexpr (ALIGN_EPI) { if (wr == 1) PG8_BAR; }
    }
    PG8_WAIT_V(0);
    if constexpr (!ALIGN_EPI) { if (wr == 0) PG8_BAR; }
    PG8_BAR;
    if constexpr (Epi::AFTER_DRAIN) { if constexpr (FP8) asm volatile("s_nop 15\n\ts_nop 15" ::: "memory"); E.fused(acc, cur, wr, wc, fr, fq, lds, wid, lane); }
#undef PG8_SA
#undef PG8_SB
#undef PG8_STAGE
#undef PG8_STAGE_A
#undef PG8_GOFF
#undef PG8_LDA
#undef PG8_LDB
#undef PG8_MMA
#undef PG8_WAIT_V
#undef PG8_WAIT_L
#undef PG8_BAR
#undef PG8_SCHED
}

typedef f32x4 Acc[2][2][4][2];

struct EpiStore {
    static constexpr bool AFTER_DRAIN = false;
    const float* cs; float sc;
    __device__ __forceinline__ void operator()(const Acc& acc, const Unit& u, int wr, int wc, int fr, int fq) const {
        bf16_t* base = (bf16_t*)u.o; int r0 = wr * 64 + fr; asm volatile("" : "+v"(r0)); const int c0 = wc * 32 + 8 * fq;
        f32x4 s[2][2];
#pragma unroll
        for (int bj = 0; bj < 2; ++bj)
#pragma unroll
            for (int n = 0; n < 2; ++n) { s[bj][n] = (f32x4){1.f, 1.f, 1.f, 1.f}; if (u.z == 0) { s[bj][n] = (f32x4){sc, sc, sc, sc}; if (cs) s[bj][n] = s[bj][n] * *(const f32x4*)(cs + u.pn * 256 + bj * HALF + c0 + 4 * n); } }
#pragma unroll
        for (int ai = 0; ai < 2; ++ai)
#pragma unroll
            for (int m = 0; m < 4; ++m) { bf16_t* rowp = base + (size_t)(r0 + ai * HALF + m * 16) * u.ldo + c0;
#pragma unroll
                for (int bj = 0; bj < 2; ++bj) { const f32x4 v0 = acc[ai][bj][m][0] * s[bj][0], v1 = acc[ai][bj][m][1] * s[bj][1];
                    u32x4 w; w.x = pk2(v0[0], v0[1]); w.y = pk2(v0[2], v0[3]); w.z = pk2(v1[0], v1[1]); w.w = pk2(v1[2], v1[3]);
                    *(u32x4*)(rowp + bj * HALF) = w; } }
    }
};
struct EpiStore8 {
    static constexpr bool AFTER_DRAIN = false;
    const float* cs; float sc0, sc1;
    __device__ __forceinline__ void operator()(const Acc& acc, const Unit& u, int wr, int wc, int fr, int fq) const {
        unsigned char* base = (unsigned char*)u.o; int r0 = wr * 64 + fr; asm volatile("" : "+v"(r0)); const int c0 = wc * 32 + 8 * fq;
        f32x4 s[2][2];
#pragma unroll
        for (int bj = 0; bj < 2; ++bj)
#pragma unroll
            for (int n = 0; n < 2; ++n) { s[bj][n] = (f32x4){sc1, sc1, sc1, sc1}; if (u.z == 0) s[bj][n] = *(const f32x4*)(cs + u.pn * 256 + bj * HALF + c0 + 4 * n) * sc0; }
#pragma unroll
        for (int ai = 0; ai < 2; ++ai)
#pragma unroll
            for (int m = 0; m < 4; ++m) { unsigned char* rowp = base + (size_t)(r0 + ai * HALF + m * 16) * u.ldo + c0;
#pragma unroll
                for (int bj = 0; bj < 2; ++bj) { const f32x4 v0 = acc[ai][bj][m][0] * s[bj][0], v1 = acc[ai][bj][m][1] * s[bj][1];
                    u32x2 w; w.x = pk4_fp8(v0[0], v0[1], v0[2], v0[3]); w.y = pk4_fp8(v1[0], v1[1], v1[2], v1[3]); *(u32x2*)(rowp + bj * HALF) = w; } }
    }
};
struct EpiRes1 {
    static constexpr bool AFTER_DRAIN = false;
    const float* x; bf16_t* h1b; unsigned char* h1f8; float* ssq;
    __device__ __forceinline__ void operator()(const Acc& acc, const Unit& u, int wr, int wc, int fr, int fq) const {
        asm volatile("" : "+v"(fr)); const int c0 = u.pn * 256 + wc * 32 + 8 * fq;
#pragma unroll
        for (int ai = 0; ai < 2; ++ai) {
            f32x4 xv[4][2][2];
#pragma unroll
            for (int m = 0; m < 4; ++m) { const size_t off = (size_t)(u.pm * 256 + ai * HALF + wr * 64 + m * 16 + fr) * DM + c0;
#pragma unroll
                for (int bj = 0; bj < 2; ++bj) { xv[m][bj][0] = *(const f32x4*)(x + off + bj * HALF); xv[m][bj][1] = *(const f32x4*)(x + off + bj * HALF + 4); } }
#pragma unroll
            for (int m = 0; m < 4; ++m) { const int grow = u.pm * 256 + ai * HALF + wr * 64 + m * 16 + fr; const size_t off = (size_t)grow * DM + c0; float ss = 0.f;
#pragma unroll
                for (int bj = 0; bj < 2; ++bj) { const f32x4 v0 = acc[ai][bj][m][0] + xv[m][bj][0], v1 = acc[ai][bj][m][1] + xv[m][bj][1];
                    u32x4 w; w.x = pk2(v0[0], v0[1]); w.y = pk2(v0[2], v0[3]); w.z = pk2(v1[0], v1[1]); w.w = pk2(v1[2], v1[3]);
                    *(u32x4*)(h1b + off + bj * HALF) = w;
                    { u32x2 w8; w8.x = pk4_fp8(v0[0], v0[1], v0[2], v0[3]); w8.y = pk4_fp8(v1[0], v1[1], v1[2], v1[3]); *(u32x2*)(h1f8 + off + bj * HALF) = w8; }
                    ss += (v0[0] * v0[0] + v0[1] * v0[1]) + (v0[2] * v0[2] + v0[3] * v0[3]) + (v1[0] * v1[0] + v1[1] * v1[1]) + (v1[2] * v1[2] + v1[3] * v1[3]); }
                ss += __shfl_xor(ss, 16); ss += __shfl_xor(ss, 32);
                if (fq == 0) ssq[(size_t)grow * 32 + u.pn * 4 + wc] = ss; }
            asm volatile("" ::: "memory");
        }
    }
};
template <bool HN> struct EpiRes2 {
    static constexpr bool AFTER_DRAIN = false; static constexpr float sc = 1.f / (P_SCALE * WVO_SCALE);
    const bf16_t* h1b; bf16_t* ho; unsigned char* hn8; const float* gain;
    __device__ __forceinline__ void operator()(const Acc& acc, const Unit& u, int wr, int wc, int fr, int fq) const {
        asm volatile("" : "+v"(fr)); const int c0 = u.pn * 256 + wc * 32 + 8 * fq;
#pragma unroll
        for (int ai = 0; ai < 2; ++ai) {
            u32x4 xv[4][2];
#pragma unroll
            for (int m = 0; m < 4; ++m) { const size_t off = (size_t)(u.pm * 256 + ai * HALF + wr * 64 + m * 16 + fr) * DM + c0;
#pragma unroll
                for (int bj = 0; bj < 2; ++bj) xv[m][bj] = *(const u32x4*)(h1b + off + bj * HALF); }
#pragma unroll
            for (int m = 0; m < 4; ++m) { const size_t off = (size_t)(u.pm * 256 + ai * HALF + wr * 64 + m * 16 + fr) * DM + c0;
#pragma unroll
                for (int bj = 0; bj < 2; ++bj) { const u32x4 w = xv[m][bj]; const f32x4 v0 = acc[ai][bj][m][0] * sc + (f32x4){bflo(w.x), bfhi(w.x), bflo(w.y), bfhi(w.y)}, v1 = acc[ai][bj][m][1] * sc + (f32x4){bflo(w.z), bfhi(w.z), bflo(w.w), bfhi(w.w)};
                    u32x4 o; o.x = pk2(v0[0], v0[1]); o.y = pk2(v0[2], v0[3]); o.z = pk2(v1[0], v1[1]); o.w = pk2(v1[2], v1[3]);
                    *(u32x4*)(ho + off + bj * HALF) = o;
                    if constexpr (HN) { const f32x4 g0 = *(const f32x4*)(gain + c0 + bj * HALF), g1 = *(const f32x4*)(gain + c0 + bj * HALF + 4); u32x2 w8; w8.x = pk4_fp8(v0[0] * g0[0], v0[1] * g0[1], v0[2] * g0[2], v0[3] * g0[3]); w8.y = pk4_fp8(v1[0] * g1[0], v1[1] * g1[1], v1[2] * g1[2], v1[3] * g1[3]);
                        *(u32x2*)(hn8 + off + bj * HALF) = w8; } } }
            asm volatile("" ::: "memory");
        }
    }
};
struct EpiHid {
    static constexpr bool AFTER_DRAIN = false;
    const LAS float* rs;
    __device__ __forceinline__ void operator()(const Acc& acc, const Unit& u, int wr, int wc, int fr, int fq) const {
        unsigned char* base = (unsigned char*)u.o; int r0 = wr * 64 + fr; asm volatile("" : "+v"(r0)); const int c0 = wc * 32 + 8 * fq;
#pragma unroll
        for (int ai = 0; ai < 2; ++ai)
#pragma unroll
            for (int m = 0; m < 4; ++m) { unsigned char* rowp = base + (size_t)(r0 + ai * HALF + m * 16) * u.ldo + c0; float h[8]; const float rsv = rs[u.z * 256 + r0 + ai * HALF + m * 16] * (1.f / W_SCALE);
#pragma unroll
                for (int n = 0; n < 2; ++n)
#pragma unroll
                    for (int j = 0; j < 4; ++j) { const float g = acc[ai][0][m][n][j] * rsv, up = acc[ai][1][m][n][j] * (rsv * HID_SCALE); h[4 * n + j] = g * up / (1.f + __expf(-g)); }
                u32x2 w; w.x = pk4_fp8(h[0], h[1], h[2], h[3]); w.y = pk4_fp8(h[4], h[5], h[6], h[7]);
                *(u32x2*)rowp = w; }
    }
};
struct EpiSoftmax {
    static constexpr bool AFTER_DRAIN = true;
    const float* ssq; unsigned char* P;
    __device__ __forceinline__ void fused(Acc& acc, const Unit& u, int wr, int wc, int fr, int fq, LAS unsigned char* lds, int wid, int lane) const {
        LAS float* R1 = (LAS float*)lds; LAS float* R2 = (LAS float*)(lds + 4096);
#pragma unroll
        for (int ai = 0; ai < 2; ++ai)
#pragma unroll
            for (int m = 0; m < 4; ++m) { const int row = ai * HALF + wr * 64 + m * 16 + fr; const int grow = u.pm * 256 + row;
                const f32x4* sp = (const f32x4*)(ssq + (size_t)grow * 32); f32x4 t = sp[0];
#pragma unroll
                for (int i = 1; i < 8; ++i) t = t + sp[i];
                const float rstd = rsqrtf(((t[0] + t[1]) + (t[2] + t[3])) * (1.f / DM) + EPS) * (1.f / WQK_SCALE); float mx = -3.0e38f;
#pragma unroll
                for (int bj = 0; bj < 2; ++bj)
#pragma unroll
                    for (int n = 0; n < 2; ++n) { f32x4 v = acc[ai][bj][m][n] * rstd; acc[ai][bj][m][n] = v; mx = fmaxf(mx, fmaxf(fmaxf(v[0], v[1]), fmaxf(v[2], v[3]))); }
                mx = fmaxf(mx, __shfl_xor(mx, 16)); mx = fmaxf(mx, __shfl_xor(mx, 32));
                if (fq == 0) R1[row * 4 + wc] = mx; }
        __syncthreads();
#pragma unroll
        for (int ai = 0; ai < 2; ++ai)
#pragma unroll
            for (int m = 0; m < 4; ++m) { const int row = ai * HALF + wr * 64 + m * 16 + fr; const f32x4 q = *(const LAS f32x4*)(R1 + row * 4);
                const float M = fmaxf(fmaxf(q[0], q[1]), fmaxf(q[2], q[3])); float sm = 0.f;
#pragma unroll
                for (int bj = 0; bj < 2; ++bj)
#pragma unroll
                    for (int n = 0; n < 2; ++n) { f32x4 v = acc[ai][bj][m][n]; v[0] = __expf(v[0] - M); v[1] = __expf(v[1] - M); v[2] = __expf(v[2] - M); v[3] = __expf(v[3] - M); acc[ai][bj][m][n] = v; sm += (v[0] + v[1]) + (v[2] + v[3]); }
                sm += __shfl_xor(sm, 16); sm += __shfl_xor(sm, 32);
                if (fq == 0) R2[row * 4 + wc] = sm; }
        __syncthreads();
        const int c0 = u.pn * 256 + wc * 32 + 8 * fq;
#pragma unroll
        for (int ai = 0; ai < 2; ++ai)
#pragma unroll
            for (int m = 0; m < 4; ++m) { const int row = ai * HALF + wr * 64 + m * 16 + fr; const int grow = u.pm * 256 + row; const f32x4 q = *(const LAS f32x4*)(R2 + row * 4);
                const float inv = P_SCALE / ((q[0] + q[1]) + (q[2] + q[3]));
#pragma unroll
                for (int bj = 0; bj < 2; ++bj) { const f32x4 v0 = acc[ai][bj][m][0] * inv, v1 = acc[ai][bj][m][1] * inv;
                    u32x2 w; w.x = pk4_fp8(v0[0], v0[1], v0[2], v0[3]); w.y = pk4_fp8(v1[0], v1[1], v1[2], v1[3]);
                    *(u32x2*)(P + (size_t)grow * 1024 + c0 + bj * HALF) = w; } }
        __syncthreads();
    }
};
}
using pg8::Unit;


#define XB_TMO      128
#define XB_XCNT(j)  (256  + 64 * (j))
#define XB_XSUB(j)  (1280 + 64 * (j))
#define XB_XGEN(j)  (2304 + 64 * (j))
#define XB_TOP      3328
#define XB_TOPGEN   3392
#define XCD_BAR_WORDS 3456
#define XB_SPIN_CAP (1u << 22)
__device__ __forceinline__ unsigned xb_ld(unsigned* p)              { return __hip_atomic_load(p, __ATOMIC_RELAXED, __HIP_MEMORY_SCOPE_AGENT); }
__device__ __forceinline__ unsigned xb_add(unsigned* p, unsigned v) { return __hip_atomic_fetch_add(p, v, __ATOMIC_RELAXED, __HIP_MEMORY_SCOPE_AGENT); }
__device__ __forceinline__ unsigned xb_xcc_id() { return (unsigned)__builtin_amdgcn_s_getreg((3 << 11) | 20) & 0xFu; }
#define XB_SPIN(cond, bar) do { unsigned _sp = 0; while (cond) { __builtin_amdgcn_s_sleep(1); \
    if ((++_sp & 255u) == 0u) { if (xb_ld(&(bar)[XB_TMO])) break; if (_sp > XB_SPIN_CAP) { atomicAdd(&(bar)[XB_TMO], 1u); break; } } } } while (0)
struct XcdBarrier { unsigned* bar; unsigned x; volatile LAS unsigned* st; };
__device__ __forceinline__ XcdBarrier xcd_barrier_post(unsigned* bar, volatile LAS unsigned* st, bool leader) {
    XcdBarrier b; b.bar = bar; b.x = xb_xcc_id(); b.st = st;
    if (leader) (void)xb_add(&bar[XB_XCNT(b.x)], 1u);
    return b;
}
__device__ __forceinline__ void xcd_barrier_complete(unsigned* bar, unsigned x, unsigned& nloc, unsigned& nx) {
    const unsigned G = gridDim.x * gridDim.y * gridDim.z;
    unsigned sum, cnt, mine, sp = 0u;
    for (;;) {
        sum = 0u; cnt = 0u; mine = 0u;
#pragma unroll
        for (unsigned j = 0; j < 16; ++j) { const unsigned c = xb_ld(&bar[XB_XCNT(j)]); sum += c; cnt += (c > 0u) ? 1u : 0u; mine = (j == x) ? c : mine; }
        if (sum == G) break;
        __builtin_amdgcn_s_sleep(1);
        if ((++sp & 255u) == 0u) { if (xb_ld(&bar[XB_TMO])) break; if (sp > XB_SPIN_CAP) { atomicAdd(&bar[XB_TMO], 1u); break; } }
    }
    nloc = mine > 0u ? mine : 1u; nx = cnt > 0u ? cnt : 1u;
}
__device__ __forceinline__ void xcd_barrier(const XcdBarrier& b, int wave_) {
    asm volatile("s_waitcnt vmcnt(0)" ::: "memory");
    __syncthreads();
    if (wave_ == 0 && lane_id_v() == 0) {
        unsigned* bar = b.bar;
        __builtin_amdgcn_s_waitcnt(0);
        unsigned nloc = b.st[0], nx = b.st[1];
        if (nloc == 0u) { xcd_barrier_complete(bar, b.x, nloc, nx); b.st[0] = nloc; b.st[1] = nx; }
        const unsigned old = xb_add(&bar[XB_XSUB(b.x)], 1u);
        const unsigned gen = old / nloc;
        if (old + 1u == (gen + 1u) * nloc) {
            __builtin_amdgcn_fence(__ATOMIC_RELEASE, "agent");
            asm volatile("s_waitcnt vmcnt(0)" ::: "memory");
            const unsigned og = xb_add(&bar[XB_TOP], 1u);
            const unsigned tg = og / nx;
            if (og + 1u == (tg + 1u) * nx) xb_add(&bar[XB_TOPGEN], 1u);
            else XB_SPIN(xb_ld(&bar[XB_TOPGEN]) == tg, bar);
            __builtin_amdgcn_fence(__ATOMIC_ACQUIRE, "agent");
            xb_add(&bar[XB_XGEN(b.x)], 1u);
            asm volatile("s_waitcnt vmcnt(0)" ::: "memory");
        } else {
            XB_SPIN(xb_ld(&bar[XB_XGEN(b.x)]) == gen, bar);
            __builtin_amdgcn_fence(__ATOMIC_ACQUIRE, "agent");
            asm volatile("s_waitcnt vmcnt(0)" ::: "memory");
        }
    }
    __syncthreads();
}

struct Params {
    const float *x, *mem, *norm_mix, *w_in, *attn_out_norm, *sink_logit, *w_gla_gf, *b_gla_gf, *w_gla_gb, *b_gla_gb, *gla_out_norm, *w_out, *norm_cross, *norm_mem,
        *w_cq, *w_ck, *w_cv, *w_co, *norm_ffn, *w_rg, *b_rg, *w_re, *b_re, *w_gate, *w_up, *w_down, *norm_final;
    float* out; unsigned char* ws; int ph_lo, ph_hi;
};

template <class RowMap>
__device__ __forceinline__ void tr_item(const float* W, int N, int Nvalid, int k0, int n0, bf16_t* dst, int Kd, const RowMap& rm, LAS float* scr, int lane) {
    const bool ok = (n0 + lane) < Nvalid; const int nc = ok ? n0 + lane : Nvalid - 1; const float* src = W + (size_t)k0 * N + nc;
    float vv[64];
#pragma unroll
    for (int kk = 0; kk < 64; ++kk) vv[kk] = src[(size_t)kk * N];
#pragma unroll
    for (int kk = 0; kk < 64; ++kk) scr[kk * 65 + lane] = ok ? vv[kk] : 0.f;
    asm volatile("s_waitcnt lgkmcnt(0)" ::: "memory");
    const int c = lane & 7;
#pragma unroll
    for (int j = 0; j < 8; ++j) { const int n = (lane >> 3) + 8 * j; const LAS float* s = scr + (8 * c) * 65 + n;
        u32x4 o; o.x = pk2(s[0], s[65]); o.y = pk2(s[2 * 65], s[3 * 65]); o.z = pk2(s[4 * 65], s[5 * 65]); o.w = pk2(s[6 * 65], s[7 * 65]);
        *(u32x4*)(dst + (size_t)rm(n0 + n) * Kd + k0 + 8 * c) = o; }
    asm volatile("s_waitcnt lgkmcnt(0)" ::: "memory");
}
template <class RowMap>
__device__ __forceinline__ void tr_item8(const float* W, int N, int k0, int n0, unsigned char* dst, int Kd, const RowMap& rm, float scale, LAS float* scr, int lane, bool nostore = false) {
    LAS unsigned* s32 = (LAS unsigned*)scr;
    {
        const int n4 = lane & 15, ks = lane >> 4; const float* src = W + (size_t)(k0 + 2 * ks) * N + n0 + 4 * n4;
        f32x4 va[16], vb[16];
#pragma unroll
        for (int i = 0; i < 16; ++i) { va[i] = __builtin_nontemporal_load((const f32x4*)(src + (size_t)(8 * i) * N)); vb[i] = __builtin_nontemporal_load((const f32x4*)(src + (size_t)(8 * i + 1) * N)); }
#pragma unroll
        for (int i = 0; i < 16; ++i)
#pragma unroll
            for (int e = 0; e < 4; ++e) s32[(4 * i + ks) * 65 + 4 * n4 + e] = pk2(va[i][e], vb[i][e]); }
    asm volatile("s_waitcnt lgkmcnt(0)" ::: "memory");
    const int c = lane & 7;
#pragma unroll
    for (int j = 0; j < 8; ++j) { const int n = (lane >> 3) + 8 * j; const LAS unsigned* s = s32 + (8 * c) * 65 + n; unsigned w[8];
#pragma unroll
        for (int i = 0; i < 8; ++i) w[i] = s[i * 65];
        u32x4 o;
        o.x = pk4_fp8(bflo(w[0]) * scale, bfhi(w[0]) * scale, bflo(w[1]) * scale, bfhi(w[1]) * scale); o.y = pk4_fp8(bflo(w[2]) * scale, bfhi(w[2]) * scale, bflo(w[3]) * scale, bfhi(w[3]) * scale);
        o.z = pk4_fp8(bflo(w[4]) * scale, bfhi(w[4]) * scale, bflo(w[5]) * scale, bfhi(w[5]) * scale); o.w = pk4_fp8(bflo(w[6]) * scale, bfhi(w[6]) * scale, bflo(w[7]) * scale, bfhi(w[7]) * scale);
        if (!nostore || (o.x == 0x12345678u && o.y == 0x9abcdef0u)) __builtin_nontemporal_store(o, (u32x4*)(dst + (size_t)rm(n0 + n) * Kd + k0 + 16 * c)); }
    asm volatile("s_waitcnt lgkmcnt(0)" ::: "memory");
}
struct RmId { int off; __device__ __forceinline__ int operator()(int n) const { return off + n; } };
struct RmGu { int base; __device__ __forceinline__ int operator()(int n) const { return base + (n >> 7) * 256 + (n & 127); } };

struct SchedP1 {
    int G, c; const char *u, *win, *memn, *wckv; char *proj, *memK, *memV;
    __device__ __forceinline__ bool next(int i, Unit& t) const {
        int L = i * G + c;
        if (L < 1216) { int pm, pn; pg8::tile_map(L, 64, 19, pm, pn); t.a = u + (size_t)pm * 256 * DM * 2; t.b = win + (size_t)pn * 256 * DM * 2; t.o = proj + ((size_t)pm * 256 * PLD + pn * 256) * 2; t.pm = pm; t.pn = pn; t.ldo = PLD; t.z = 1; return true; }
        L -= 1216; if (L >= 64) return false;
        const int pm = L & 3, pn = L >> 2; t.a = memn + (size_t)pm * 256 * DM * 2; t.b = wckv + (size_t)pn * 256 * DM * 2;
        t.o = (pn < 8 ? memK : memV) + ((size_t)pm * 256 * DM + (pn & 7) * 256) * 2; t.pm = pm; t.pn = pn; t.ldo = DM; t.z = 1; return true;
    }
};
struct SchedPre {
    int G, c; const char *memK, *memV, *wcq, *wco; char *wqk, *wvo;
    __device__ __forceinline__ bool next(int i, Unit& t) const {
        int L = i * G + c; if (L >= 256 * PRE_REP) return false;
        L &= 255;
        const int q = L & 127, b = q >> 5, h = (q >> 3) & 3, ct = q & 7;
        if (L < 128) { t.a = memK + ((size_t)b * 256 * DM + h * 512) * 2; t.b = wcq + ((size_t)ct * 256 * DM + h * 512) * 2; t.o = wqk + (((size_t)b * 1024 + h * 256) * DM + ct * 256); t.pm = 0; t.pn = ct; t.ldo = DM; t.z = 0; }
        else { t.a = wco + ((size_t)ct * 256 * DM + h * 512) * 2; t.b = memV + ((size_t)b * 256 * DM + h * 512) * 2; t.o = wvo + (((size_t)b * 2048 + ct * 256) * 1024 + h * 256); t.pm = 0; t.pn = 0; t.ldo = 1024; t.z = 1; }
        return true;
    }
};
struct SchedTok {
    int G, c, nN; const char *A, *B; size_t astride  , bstride_tile  , bstride_batch;
    __device__ __forceinline__ bool next(int i, Unit& t) const {
        const int L = i * G + c; if (L >= 64 * nN) return false;
        int pm, pn; pg8::tile_map(L, 64, nN, pm, pn);
        t.a = A + (size_t)pm * astride; t.b = B + (size_t)(pm >> 4) * bstride_batch + (size_t)pn * bstride_tile; t.o = nullptr; t.pm = pm; t.pn = pn; t.ldo = 0; t.z = 0; return true;
    }
};
struct SchedOne { Unit u0; __device__ __forceinline__ bool next(int i, Unit& t) const { if (i > 0) return false; t = u0; return true; } };
struct SchedMoe {
    const LAS int* T; const int* list; const float* rstd3; LAS float* rs;
    int G, c, nblk; const LAS int* blk_e; const char *A, *B; char* O; size_t astride, bexp, btile, ostride; int ocol  , ldo, reps;
    __device__ __forceinline__ bool next(int i, Unit& t) const {
        int L = i * G + c; if (L >= nblk * 8 * reps) return false;
        if (L >= nblk * 8) L -= nblk * 8;
        int pm, pn; pg8::tile_map(L, nblk, 8, pm, pn); const int e = __builtin_amdgcn_readfirstlane(blk_e[pm]);
        t.a = A + (size_t)pm * astride; t.b = B + (size_t)e * bexp + (size_t)pn * btile; t.o = O + (size_t)pm * ostride + (size_t)pn * ocol; t.pm = pm; t.pn = pn; t.ldo = ldo; t.z = list ? i % 3 : 1; return true;
    }
    __device__ __forceinline__ int rowtok(const Unit& u, int r) const { const int e = __builtin_amdgcn_readfirstlane(blk_e[u.pm]); const int idx = (u.pm - __builtin_amdgcn_readfirstlane(T[1 + e])) * 256 + r; const int cnt = __builtin_amdgcn_readfirstlane(T[240 + e]);
        return idx < cnt ? list[e * 16384 + idx] : 0; }
    __device__ __forceinline__ void rs_fill(const Unit& u, int tid) const { if (tid < 256) rs[u.z * 256 + tid] = rstd3[rowtok(u, tid)]; }
};

__device__ __forceinline__ void moe_table(const unsigned* cnt, LAS int* T, int tid_) {
    if (tid_ == 0) { int acc = 0;
        for (int e = 0; e < NEXP; ++e) { T[1 + e] = acc; T[240 + e] = (int)cnt[e]; const int nb = ((int)cnt[e] + 255) >> 8; for (int j = 0; j < nb; ++j) T[64 + acc + j] = e; acc += nb; }
        T[1 + NEXP] = acc; T[0] = acc; }
    __syncthreads();
}

__global__ void __launch_bounds__(512, 2) fwd_mega(Params p) {
    extern __shared__ __attribute__((aligned(16))) unsigned char lds_raw[];
    LAS unsigned char* lds = (LAS unsigned char*)lds_raw;
    const unsigned ldsb = (unsigned)(size_t)lds;
    const int wave = __builtin_amdgcn_readfirstlane((int)threadIdx.x >> 6);
#define PH_IDS const int lane = lane_id_v(), tid = wave * 64 + lane; (void)tid; (void)lane;
    const int G = gridDim.x, bid = blockIdx.x;
    const int gw = bid * 8 + wave, NGW = G * 8;
    unsigned char* const ws = p.ws;
#define WGU ((unsigned char*)(ws + WS_WGU))
#define WD ((unsigned char*)(ws + WS_WD))
#define WIN ((bf16_t*)(ws + WS_WIN))
#define WCKV ((bf16_t*)(ws + WS_WCKV))
#define WOUT ((bf16_t*)(ws + WS_WOUT))
#define WCO ((bf16_t*)(ws + WS_WCO))
#define WCQ ((bf16_t*)(ws + WS_WCQ))
#define WQK ((unsigned char*)(ws + WS_WQK))
#define WVO ((unsigned char*)(ws + WS_WVO))
#define U ((bf16_t*)(ws + WS_U))
#define H1B ((bf16_t*)(ws + WS_H1B))
#define H1F8 ((unsigned char*)(ws + WS_H1F8))
#define HN8 ((unsigned char*)(ws + WS_H1F8))
#define LIST ((int*)(ws + WS_FIMG))
#define MEMN ((bf16_t*)(ws + WS_MEMN))
#define MEMK ((bf16_t*)(ws + WS_MEMK))
#define MEMV ((bf16_t*)(ws + WS_MEMV))
#define PROJ ((bf16_t*)(ws + WS_PROJ))
#define PB ((unsigned char*)(ws + WS_P))
#define GQ ((bf16_t*)(ws + WS_GQ))
#define GK ((bf16_t*)(ws + WS_GK))
#define GD ((float*)(ws + WS_GD))
#define O1 ((bf16_t*)(ws + WS_O1))
#define O2 ((bf16_t*)(ws + WS_O2))
#define O3 ((bf16_t*)(ws + WS_O3))
#define A2 ((bf16_t*)(ws + WS_A2))
#define SSQ ((float*)(ws + WS_SSQ))
#define XS ((unsigned char*)(ws + WS_XS))
#define HID ((unsigned char*)(ws + WS_HID))
#define YS ((unsigned char*)(ws + WS_YS))
#define WR ((float*)(ws + WS_WR))
#define FIMG ((float*)(ws + WS_FIMG))
#define SEGD ((float*)(ws + WS_SEGD))
#define ASG_E ((int*)(ws + WS_ASG))
#define ASG_S (ASG_E + 2 * NT)
#define ASG_G ((float*)(ASG_S + 2 * NT))
#define RSTD3 (ASG_G + 2 * NT)
#define DEST ((int*)(RSTD3 + NT))
#define CNT ((unsigned*)(ws + WS_CTL) + CW_CNT)
    float* H = p.out;
    LAS int* TBL = (LAS int*)(lds + MISC_OFF);
    const int lo = p.ph_lo, hi = p.ph_hi;
#define IN(k) (lo <= (k) && (k) < hi)
    volatile LAS unsigned* XST = (volatile LAS unsigned*)(lds + MISC_OFF + 4096);
    { PH_IDS if (tid < 4) XST[tid] = 0u;
    __syncthreads();
    }
    XcdBarrier xbar; { PH_IDS xbar = xcd_barrier_post((unsigned*)(ws + WS_CTL) + CW_BAR, XST, tid == 0); }
#define SEAM(k) do { if (IN(k) && IN((k) + 1)) xcd_barrier(xbar, wave); } while (0)

    if (IN(0)) for (int rp_ = 0; rp_ < (RPT == 0 ? 2 : 1); ++rp_) { PH_IDS
        LAS float* scr = (LAS float*)(lds + wave * 16640);
        constexpr int I_IN = 32 * 76, I_SQ = 32 * 32, I_G = 16 * 16, I_D = 8 * 32;
        for (int it = gw; it < (I_IN + 2 * I_SQ) * P0T_REP; it += NGW) {
            int r = it % (I_IN + 2 * I_SQ);
            if (r < I_IN) { const int kb = r / 76, nb = r % 76; tr_item(p.w_in, 4640, 4640, 64 * kb, 64 * nb, WIN, DM, RmId{0}, scr, lane); continue; } r -= I_IN;
            if (r < I_SQ) { tr_item(p.w_ck, DM, DM, 64 * (r >> 5), 64 * (r & 31), WCKV, DM, RmId{0}, scr, lane); continue; } r -= I_SQ;
            tr_item(p.w_cv, DM, DM, 64 * (r >> 5), 64 * (r & 31), WCKV, DM, RmId{2048}, scr, lane);
        }
        {
            f32x4 cv[8], n1[8], n2[8];
            constexpr int NR = NT + NB * MEML;
            auto rowp = [&](int m) -> const f32x4* { return (const f32x4*)(m < NT ? p.x + (size_t)m * DM : p.mem + (size_t)(m - NT) * DM) + 2 * lane; };
            auto rload = [&](int m, f32x4 (&d)[8]) { const f32x4* xr = rowp(m < NR ? m : gw);
#pragma unroll
                for (int j = 0; j < 4; ++j) { d[2 * j] = xr[128 * j]; d[2 * j + 1] = xr[128 * j + 1]; } };
            for (int prr = 0; prr < P0R_REP; ++prr) {
            if (gw < NR) { rload(gw, cv); rload(gw + NGW, n1); }
            for (int m = gw; m < NR; m += NGW) {
                rload(m + 2 * NGW, n2);
                float s = 0.f;
#pragma unroll
                for (int j = 0; j < 8; ++j) s += (cv[j][0] * cv[j][0] + cv[j][1] * cv[j][1]) + (cv[j][2] * cv[j][2] + cv[j][3] * cv[j][3]);
                const float rstd = rsqrtf(wave_sum(s) * (1.f / DM) + EPS);
                const f32x4* gr = (const f32x4*)(m < NT ? p.norm_mix : p.norm_mem) + 2 * lane; u32x4* o = (u32x4*)(m < NT ? U + (size_t)m * DM : MEMN + (size_t)(m - NT) * DM) + lane;
#pragma unroll
                for (int j = 0; j < 4; ++j) { const f32x4 g0 = gr[128 * j], g1 = gr[128 * j + 1]; const f32x4 a = cv[2 * j], c = cv[2 * j + 1]; u32x4 w;
                    w.x = pk2(a[0] * rstd * g0[0], a[1] * rstd * g0[1]); w.y = pk2(a[2] * rstd * g0[2], a[3] * rstd * g0[3]); w.z = pk2(c[0] * rstd * g1[0], c[1] * rstd * g1[1]); w.w = pk2(c[2] * rstd * g1[2], c[3] * rstd * g1[3]);
                    o[64 * j] = w; }
#pragma unroll
                for (int j = 0; j < 8; ++j) { cv[j] = n1[j]; n1[j] = n2[j]; }
            }
            }
        }
        __syncthreads();
    }
    SEAM(0);

    if (IN(1)) for (int rp_ = 0; rp_ < (RPT == 1 ? 2 : 1); ++rp_) { PH_IDS
        SchedP1 S{G, bid, (const char*)U, (const char*)WIN, (const char*)MEMN, (const char*)WCKV, (char*)PROJ, (char*)MEMK, (char*)MEMV};
        pg8::EpiStore E{nullptr, 1.f};
        LAS float* scr = (LAS float*)(lds + wave * 16640);
        constexpr int I_G = 16 * 16, I_D = 8 * 32, NE = NEXP * (2 * I_G + I_D);
        int kdone = 0; const int ktot = (NE * (1 + P0E_REP) - gw + NGW - 1) / NGW;
        struct EDesc { const float* W; unsigned char* dst; int N, Kd, k0, n0, rb, gu; };
        auto edesc = [&](int it) { EDesc d; const int q = it % NE; const int typ = q / (NEXP * 256), e = NEXP - 1 - (q % (NEXP * 256)) / 256, r = q % 256;
            if (typ == 0) { d.W = p.w_down + (size_t)e * DFF * DM; d.N = DM; d.k0 = 128 * (r >> 5); d.n0 = 64 * (r & 31); d.dst = WD + (size_t)e * 2048 * DFF; d.Kd = DFF; d.rb = 0; d.gu = 0; }
            else { d.W = (typ == 1 ? p.w_up : p.w_gate) + (size_t)e * DM * DFF; d.N = DFF; d.k0 = 128 * (r >> 4); d.n0 = 64 * (r & 15); d.dst = WGU + (size_t)e * 2048 * DM; d.Kd = DM; d.rb = (typ == 1) ? 128 : 0; d.gu = 1; }
            return d; };
        auto prep_chunk = [&](int nitems) {
            LAS unsigned* s32 = (LAS unsigned*)scr; const int n4 = lane & 15, ks = lane >> 4, cc = lane & 7;
            int left = ktot - kdone; if (left > nitems) left = nitems;
            if (left > 0) {
                f32x4 va[16], vb[16];
                auto eload = [&](const EDesc& d) { const float* sp = d.W + (size_t)(d.k0 + 2 * ks) * d.N + d.n0 + 4 * n4;
#pragma unroll
                    for (int i = 0; i < 16; ++i) { va[i] = __builtin_nontemporal_load((const f32x4*)(sp + (size_t)(8 * i) * d.N)); vb[i] = __builtin_nontemporal_load((const f32x4*)(sp + (size_t)(8 * i + 1) * d.N)); } };
                EDesc dcur = edesc(gw + kdone * NGW); eload(dcur);
                for (int c = 0; c < left; ++c, ++kdone) {
#pragma unroll
                    for (int i = 0; i < 16; ++i)
#pragma unroll
                        for (int e = 0; e < 4; ++e) s32[(4 * i + ks) * 65 + 4 * n4 + e] = pk2(va[i][e], vb[i][e]);
                    asm volatile("s_waitcnt lgkmcnt(0)" ::: "memory");
                    EDesc dnext = dcur; if (c + 1 < left) { dnext = edesc(gw + (kdone + 1) * NGW); eload(dnext); }
#pragma unroll
                    for (int j = 0; j < 8; ++j) { const int n = (lane >> 3) + 8 * j; const LAS unsigned* s = s32 + (8 * cc) * 65 + n; unsigned w[8];
#pragma unroll
                        for (int i = 0; i < 8; ++i) w[i] = s[i * 65];
                        u32x4 o;
                        o.x = pk4_fp8(bflo(w[0]) * W_SCALE, bfhi(w[0]) * W_SCALE, bflo(w[1]) * W_SCALE, bfhi(w[1]) * W_SCALE); o.y = pk4_fp8(bflo(w[2]) * W_SCALE, bfhi(w[2]) * W_SCALE, bflo(w[3]) * W_SCALE, bfhi(w[3]) * W_SCALE);
                        o.z = pk4_fp8(bflo(w[4]) * W_SCALE, bfhi(w[4]) * W_SCALE, bflo(w[5]) * W_SCALE, bfhi(w[5]) * W_SCALE); o.w = pk4_fp8(bflo(w[6]) * W_SCALE, bfhi(w[6]) * W_SCALE, bflo(w[7]) * W_SCALE, bfhi(w[7]) * W_SCALE);
                        const int nn = dcur.n0 + n; const int row = dcur.gu ? dcur.rb + (nn >> 7) * 256 + (nn & 127) : nn;
                        if (!(P0E_NOSTORE && gw + kdone * NGW >= NE) || o.x == 0x12345678u) __builtin_nontemporal_store(o, (u32x4*)(dcur.dst + (size_t)row * dcur.Kd + dcur.k0 + 16 * cc)); }
                    asm volatile("s_waitcnt lgkmcnt(0)" ::: "memory");
                    dcur = dnext; } }
            __syncthreads(); };
        auto extra_prep = [&]() {
            constexpr int I_SQ = 32 * 32;
            for (int it = gw; it < 2 * I_SQ; it += NGW) { const int r = it & (I_SQ - 1);
                if (it < I_SQ) tr_item(p.w_out, DM, DM, 64 * (r >> 5), 64 * (r & 31), WOUT, DM, RmId{0}, scr, lane); else tr_item(p.w_co, DM, DM, 64 * (r >> 5), 64 * (r & 31), WCO, DM, RmId{0}, scr, lane); }
        for (int i = gw * 64 + lane; i < DM * DM / 8; i += NGW * 64) { const f32x4 a = ((const f32x4*)p.w_cq)[2 * i], b = ((const f32x4*)p.w_cq)[2 * i + 1];
            u32x4 w; w.x = pk2(a[0], a[1]); w.y = pk2(a[2], a[3]); w.z = pk2(b[0], b[1]); w.w = pk2(b[2], b[3]); ((u32x4*)WCQ)[i] = w; }
        for (int i = gw * 64 + lane; i < 128 * 3 * 64; i += NGW * 64) { const int l = i & 63, ct = (i >> 6) % 3, kb = i / 192; const int j = 16 * ct + (l & 15); f32x4 o;
#pragma unroll
            for (int e = 0; e < 4; ++e) { const int k = 16 * kb + 4 * (l >> 4) + e; float w = 0.f; if (j < 4) w = p.w_rg[k * 4 + j]; else if (j < 36) w = p.w_re[k * 32 + (j - 4)]; o[e] = w * p.norm_ffn[k]; }
            ((f32x4*)WR)[i] = o; }
            __syncthreads(); };
        int nun = 0; { Unit t; while (S.next(nun, t)) ++nun; }
        struct SchedRange { const SchedP1* S; int a, b; __device__ __forceinline__ bool next(int i, Unit& t) const { return (a + i < b) && S->next(a + i, t); } };
        int split = 2 * ((((bid >> 3) & 7) * 3) >> 3); if (split > nun) split = nun;
        if (split > 0) { SchedRange R{&S, 0, split}; pg8::gemm_phase<pg8::EpiStore, SchedRange, true>(lds, DM * 2, DM / 64, R, E, wave); }
        extra_prep(); prep_chunk(ktot);
        if (split < nun) { SchedRange R{&S, split, nun}; pg8::gemm_phase<pg8::EpiStore, SchedRange, true>(lds, DM * 2, DM / 64, R, E, wave); }
    }
    SEAM(1);

    if (IN(2)) for (int rp_ = 0; rp_ < (RPT == 2 ? 2 : 1); ++rp_) { PH_IDS }

    if (IN(3)) for (int rp_ = 0; rp_ < (RPT == 3 ? 2 : 1); ++rp_) { PH_IDS
        const int r32 = lane & 31, hh = lane >> 5, q4 = (lane & 15) >> 2, p4 = lane & 3, blk = (lane >> 4) & 1;
        {
            constexpr int L_B = 0, L_Q = 32768, L_KI = L_Q + 17408, L_KD = L_KI + 17408, L_V = L_KD + 17408, L_P = L_V + 33792, L_TT = L_P + 9216, L_D = L_TT + 1024;
            static_assert(L_D + 512 <= MISC_OFF, "G1 LDS");
            LAS float* BB_ = (LAS float*)(lds + L_B); LAS float* TT = (LAS float*)(lds + L_TT); LAS float* DD = (LAS float*)(lds + L_D);
            const int gct = wave & 1, gdt = wave >> 1;
            for (int it0 = bid; it0 < 256 * SCAN_REP; it0 += G) { const int it = it0 & 255;
                const int dir = it & 1, h = (it >> 1) & 3, b = (it >> 3) & 3, sg = it >> 5; const int vs = wave;
                const size_t tile0 = (size_t)((b * 4 + h) * 2 + dir) * 64; bf16_t* OUT = dir ? O3 : O2;
                f32x16 St[4];
#pragma unroll
                for (int db = 0; db < 4; ++db)
#pragma unroll
                    for (int i = 0; i < 16; ++i) St[db][i] = 0.f;
                bf16x8 bw; float gbias;
                { const float* wgp = (dir ? p.w_gla_gb : p.w_gla_gf) + h * 128 + 32 * gdt + r32; float wg8[8];
#pragma unroll
                  for (int j = 0; j < 8; ++j) wg8[j] = wgp[(8 * hh + j) * 512];
                  bw = pack8(wg8); gbias = (dir ? p.b_gla_gb : p.b_gla_gf)[h * 128 + 32 * gdt + r32]; }
                float segp = 1.f;
                bf16x8 n_alr, n_pq[2], n_pk[2], n_pv[4];
                auto cload = [&](int n_) { const int t0_ = b * SEQ + n_ * 64;
                    n_alr = *(const bf16x8*)(PROJ + (size_t)(t0_ + 32 * gct + r32) * PLD + C_LRF + 16 * dir + 8 * hh);
#pragma unroll
                    for (int rep = 0; rep < 2; ++rep) { const int pidx = tid + 512 * rep, c = pidx >> 4, d8 = (pidx & 15) * 8; const size_t rowoff = (size_t)(t0_ + c) * PLD + h * 128 + d8;
                        n_pq[rep] = *(const bf16x8*)(PROJ + rowoff + C_QG); n_pk[rep] = *(const bf16x8*)(PROJ + rowoff + C_KG); }
#pragma unroll
                    for (int rep = 0; rep < 4; ++rep) { const int pidx = tid + 512 * rep, row = pidx >> 5, ch = pidx & 31; n_pv[rep] = *(const bf16x8*)(PROJ + (size_t)(t0_ + row) * PLD + C_VG + h * 256 + ch * 8); } };
                cload(dir ? 63 - 8 * sg : 8 * sg);
                for (int i8 = 0; i8 < 8; ++i8) {
                    const int i = 8 * sg + i8; const int n = dir ? 63 - i : i; const int t0 = b * SEQ + n * 64;
                    { f32x16 z;
#pragma unroll
                      for (int q = 0; q < 16; ++q) z[q] = 0.f;
                      f32x16 Gt = MFMA32(n_alr, bw, z);
#pragma unroll
                      for (int q = 0; q < 16; ++q) { const float pre = Gt[q] + gbias; Gt[q] = (fminf(pre, 0.f) - __logf(1.f + __expf(-fabsf(pre)))) * (1.f / 16.f); }
                      float T[4], Uo[4], off[4]; float run = 0.f;
                      if (dir == 0) {
#pragma unroll
                          for (int g = 0; g < 4; ++g) { Gt[4 * g + 1] += Gt[4 * g]; Gt[4 * g + 2] += Gt[4 * g + 1]; Gt[4 * g + 3] += Gt[4 * g + 2]; T[g] = Gt[4 * g + 3]; }
                      } else {
#pragma unroll
                          for (int g = 0; g < 4; ++g) { Gt[4 * g + 2] += Gt[4 * g + 3]; Gt[4 * g + 1] += Gt[4 * g + 2]; Gt[4 * g] += Gt[4 * g + 1]; T[g] = Gt[4 * g]; }
                      }
#pragma unroll
                      for (int g = 0; g < 4; ++g) Uo[g] = __shfl_xor(T[g], 32);
                      if (dir == 0) {
#pragma unroll
                          for (int g = 0; g < 4; ++g) { off[g] = run + (hh ? Uo[g] : 0.f); run += T[g] + Uo[g]; }
                      } else {
#pragma unroll
                          for (int g = 3; g >= 0; --g) { off[g] = run + (hh ? 0.f : Uo[g]); run += T[g] + Uo[g]; }
                      }
                      const int dcol = 32 * gdt + r32;
#pragma unroll
                      for (int q = 0; q < 16; ++q) BB_[(32 * gct + crow(q, hh)) * 128 + dcol] = Gt[q] + off[q >> 2];
                      if (hh == 0) TT[gct * 128 + dcol] = run; }
                    lds_barrier();
#pragma unroll
                    for (int rep = 0; rep < 2; ++rep) { const int pidx = tid + 512 * rep, c = pidx >> 4, d8 = (pidx & 15) * 8;
                        float q[8], k[8]; unpack8(n_pq[rep], q); unpack8(n_pk[rep], k);
                        const LAS float* Bd = BB_ + c * 128 + d8; const f32x4 b0 = *(const LAS f32x4*)Bd, b1 = *(const LAS f32x4*)(Bd + 4);
                        const f32x4 ta0 = *(const LAS f32x4*)(TT + d8), ta1 = *(const LAS f32x4*)(TT + d8 + 4), tb0 = *(const LAS f32x4*)(TT + 128 + d8), tb1 = *(const LAS f32x4*)(TT + 128 + d8 + 4);
                        const bool fix = dir ? (c < 32) : (c >= 32);
                        float qd[8], ki[8], kd[8];
#pragma unroll
                        for (int j = 0; j < 8; ++j) { const float t0v = j < 4 ? ta0[j] : ta1[j - 4], t1v = j < 4 ? tb0[j] : tb1[j - 4]; const float bb = (j < 4 ? b0[j] : b1[j - 4]) + (fix ? (dir ? t1v : t0v) : 0.f);
                            const float e = __expf(bb); qd[j] = q[j] * 0.08838834764831845f * e; ki[j] = k[j] * __expf(-bb); kd[j] = k[j] * __expf((t0v + t1v) - bb); }
                        const bf16x8 qv = pack8(qd);
                        *(LAS bf16x8*)(lds + L_Q + c * 272 + d8 * 2) = qv; *(LAS bf16x8*)(lds + L_KI + c * 272 + d8 * 2) = pack8(ki); *(LAS bf16x8*)(lds + L_KD + c * 272 + d8 * 2) = pack8(kd);
                        *(bf16x8*)(GQ + ((tile0 + n) * 64 + c) * 128 + d8) = qv; }
#pragma unroll
                    for (int rep = 0; rep < 4; ++rep) { const int pidx = tid + 512 * rep, row = pidx >> 5, ch = pidx & 31; *(LAS bf16x8*)(lds + L_V + row * 528 + ch * 16) = n_pv[rep]; }
                    if (i8 + 1 < 8) cload(dir ? n - 1 : n + 1);
                    if (tid < 128) { const float dec = __expf(TT[tid] + TT[128 + tid]); DD[tid] = dec; GD[(tile0 + n) * 128 + tid] = dec; segp *= dec; }
                    lds_barrier();
                    if (wave < 4) { const int st = wave >> 1, ct = wave & 1; f32x16 x;
#pragma unroll
                        for (int q = 0; q < 16; ++q) x[q] = 0.f;
#pragma unroll
                        for (int ks = 0; ks < 8; ++ks) { const bf16x8 ak = *(const LAS bf16x8*)(lds + L_KI + (32 * st + r32) * 272 + (16 * ks + 8 * hh) * 2), bq = *(const LAS bf16x8*)(lds + L_Q + (32 * ct + r32) * 272 + (16 * ks + 8 * hh) * 2);
                            x = MFMA32(ak, bq, x); }
                        const int cpos = 32 * ct + r32;
#pragma unroll
                        for (int g = 0; g < 4; ++g) { float m4[4];
#pragma unroll
                            for (int j = 0; j < 4; ++j) { const int s = 32 * st + 8 * g + 4 * hh + j; const bool keep = dir ? (s >= cpos) : (s <= cpos); m4[j] = keep ? x[4 * g + j] : 0.f; }
                            u32x2 w; w.x = pk2(m4[0], m4[1]); w.y = pk2(m4[2], m4[3]); *(LAS u32x2*)(lds + L_P + cpos * 144 + (32 * st + 8 * g + 4 * hh) * 2) = w; } }
                    lds_barrier();
                    { f32x16 o[2];
#pragma unroll
                      for (int ct = 0; ct < 2; ++ct)
#pragma unroll
                          for (int j = 0; j < 16; ++j) o[ct][j] = 0.f;
#pragma unroll
                      for (int kk = 0; kk < 4; ++kk) { const unsigned va = ldsb + L_V + (16 * kk + 8 * hh + q4) * 528 + (32 * vs + 16 * blk + 4 * p4) * 2; const bf16x8 av = tr_read2(va, va + 4 * 528);
#pragma unroll
                          for (int ct = 0; ct < 2; ++ct) { const bf16x8 bp = *(const LAS bf16x8*)(lds + L_P + (32 * ct + r32) * 144 + (16 * kk + 8 * hh) * 2); o[ct] = MFMA32(av, bp, o[ct]); } }
#pragma unroll
                      for (int db = 0; db < 4; ++db)
#pragma unroll
                          for (int s = 0; s < 2; ++s) { const bf16x8 xs = pack_step(St[db], s);
#pragma unroll
                              for (int ct = 0; ct < 2; ++ct) { const LAS unsigned char* qp = lds + L_Q + (32 * ct + r32) * 272 + (32 * db + 16 * s + 4 * hh) * 2;
                                  const s16x4 lo4 = *(const LAS s16x4*)qp, hi4 = *(const LAS s16x4*)(qp + 16); const bf16x8 bq = __builtin_shufflevector(lo4, hi4, 0, 1, 2, 3, 4, 5, 6, 7);
                                  o[ct] = MFMA32(xs, bq, o[ct]); } }
#pragma unroll
                      for (int ct = 0; ct < 2; ++ct) { bf16_t* orow = OUT + (size_t)(t0 + 32 * ct + r32) * 1024 + h * 256 + 32 * vs + 4 * hh;
#pragma unroll
                          for (int g = 0; g < 4; ++g) { u32x2 w; w.x = pk2(o[ct][4 * g], o[ct][4 * g + 1]); w.y = pk2(o[ct][4 * g + 2], o[ct][4 * g + 3]); *(u32x2*)(orow + 8 * g) = w; } } }
#pragma unroll
                    for (int db = 0; db < 4; ++db) {
#pragma unroll
                        for (int g = 0; g < 4; ++g) { const f32x4 dv = *(const LAS f32x4*)(DD + 32 * db + 8 * g + 4 * hh);
#pragma unroll
                            for (int j = 0; j < 4; ++j) St[db][4 * g + j] *= dv[j]; } }
#pragma unroll
                    for (int kk = 0; kk < 4; ++kk) { bf16x8 bv, ak[4];
                        tr_scan10(ldsb + L_V + (16 * kk + 8 * hh + q4) * 528 + (32 * vs + 16 * blk + 4 * p4) * 2, ldsb + L_KD + (16 * kk + 8 * hh + q4) * 272 + (16 * blk + 4 * p4) * 2, bv, ak);
#pragma unroll
                        for (int db = 0; db < 4; ++db) St[db] = MFMA32(ak[db], bv, St[db]); }
                    lds_barrier();
                }
                float* fi = FIMG + ((size_t)(it * 8 + wave) * 64) * 64 + lane;
#pragma unroll
                for (int db = 0; db < 4; ++db)
#pragma unroll
                    for (int r = 0; r < 16; ++r) fi[(db * 16 + r) * 64] = St[db][r];
                if (tid < 128) SEGD[it * 128 + tid] = segp;
            }
            lds_barrier();
        }
        {
            constexpr int A_K = 0, A_V = 33792, A_SS = 67584;
            for (int it0 = bid; it0 < NB * (SEQ / 32) * ATT_REP; it0 += G) { const int it = it0 & 511;
                const int b = it >> 7, qb = it & 127, q0 = qb * 32; const int hq = wave, kvh = wave >> 2;
                const float slope = exp2f(-(float)(hq + 1)); const float sink = p.sink_logit[hq];
                bf16x8 qf[8];
#pragma unroll
                for (int s = 0; s < 8; ++s) qf[s] = *(const bf16x8*)(PROJ + (size_t)(b * SEQ + q0 + r32) * PLD + C_QA + hq * 128 + 16 * s + 8 * hh);
                f32x16 ot[4];
#pragma unroll
                for (int dt = 0; dt < 4; ++dt)
#pragma unroll
                    for (int i = 0; i < 16; ++i) ot[dt][i] = 0.f;
                float mrun = sink, lrun = 1.f; const int qpos = q0 + r32;
                int ktlo = 0, kthi = 4;
                while (q0 - 128 + 64 * ktlo + 63 < 0) ++ktlo;
                while (q0 - 128 + 64 * kthi >= SEQ) --kthi;
                bf16x8 pk_[4], pv_[4];
                auto kvload = [&](int kt) { const int k0 = q0 - 128 + 64 * kt;
#pragma unroll
                    for (int rep = 0; rep < 4; ++rep) { const int pidx = tid + 512 * rep, row = pidx >> 5, ch = pidx & 31; int kp = k0 + row; kp = kp < 0 ? 0 : (kp >= SEQ ? SEQ - 1 : kp);
                        const bf16_t* src = PROJ + (size_t)(b * SEQ + kp) * PLD; pk_[rep] = *(const bf16x8*)(src + C_KA + ch * 8); pv_[rep] = *(const bf16x8*)(src + C_VA + ch * 8); } };
                kvload(ktlo);
                for (int kt = ktlo; kt <= kthi; ++kt) {
                    const int k0 = q0 - 128 + 64 * kt;
                    lds_barrier();
#pragma unroll
                    for (int rep = 0; rep < 4; ++rep) { const int pidx = tid + 512 * rep, row = pidx >> 5, ch = pidx & 31;
                        *(LAS bf16x8*)(lds + A_K + row * 528 + ch * 16) = pk_[rep]; *(LAS bf16x8*)(lds + A_V + row * 528 + ch * 16) = pv_[rep]; }
                    lds_barrier();
                    if (kt < kthi) kvload(kt + 1);
                    f32x16 sc[2];
#pragma unroll
                    for (int kt2 = 0; kt2 < 2; ++kt2) {
#pragma unroll
                        for (int i = 0; i < 16; ++i) sc[kt2][i] = 0.f;
#pragma unroll
                        for (int s = 0; s < 8; ++s) { const bf16x8 ak = *(const LAS bf16x8*)(lds + A_K + (32 * kt2 + r32) * 528 + (kvh * 128 + 16 * s + 8 * hh) * 2); sc[kt2] = MFMA32(ak, qf[s], sc[kt2]); } }
                    float tmax = -3.0e38f; const float d0f = (float)(k0 - qpos + 4 * hh);
                    const bool edge = (kt == 0) || (kt == 4) || (k0 < 0) || (k0 + 64 > SEQ);
#pragma unroll
                    for (int kt2 = 0; kt2 < 2; ++kt2)
#pragma unroll
                        for (int i = 0; i < 16; ++i) { const float rf = d0f + (float)(32 * kt2 + (i & 3) + 8 * (i >> 2)); float v = sc[kt2][i] * 0.08838834764831845f - slope * fabsf(rf);
                            if (edge) { const float kp = rf + (float)qpos; v = (fabsf(rf) <= 128.f && kp >= 0.f && kp < (float)SEQ) ? v : -3.0e38f; }
                            sc[kt2][i] = v; tmax = fmaxf(tmax, v); }
                    tmax = fmaxf(tmax, __shfl_xor(tmax, 32));
                    const float mnew = fmaxf(mrun, tmax), alpha = __expf(mrun - mnew); float ps = 0.f;
#pragma unroll
                    for (int kt2 = 0; kt2 < 2; ++kt2)
#pragma unroll
                        for (int i = 0; i < 16; ++i) { const float pv = __expf(sc[kt2][i] - mnew); sc[kt2][i] = pv; ps += pv; }
                    ps += __shfl_xor(ps, 32);
                    lrun = lrun * alpha + ps; mrun = mnew;
#pragma unroll
                    for (int dt = 0; dt < 4; ++dt)
#pragma unroll
                        for (int i = 0; i < 16; ++i) ot[dt][i] *= alpha;
#pragma unroll
                    for (int kk = 0; kk < 4; ++kk) { const bf16x8 bp = pack_step(sc[kk >> 1], kk & 1); bf16x8 av[4];
                        tr8<64, 4224>(ldsb + A_V + (16 * kk + 4 * hh + q4) * 528 + (kvh * 128 + 16 * blk + 4 * p4) * 2, av);
#pragma unroll
                        for (int dt = 0; dt < 4; ++dt) ot[dt] = MFMA32(av[dt], bp, ot[dt]); }
                }
                const float linv = 1.f / lrun; float ss = 0.f;
#pragma unroll
                for (int dt = 0; dt < 4; ++dt)
#pragma unroll
                    for (int i = 0; i < 16; ++i) { ot[dt][i] *= linv; ss += ot[dt][i] * ot[dt][i]; }
                ss += __shfl_xor(ss, 32);
                LAS float* SS = (LAS float*)(lds + A_SS);
                lds_barrier();
                if (hh == 0) SS[hq * 32 + r32] = ss;
                lds_barrier();
                float tot = 0.f;
#pragma unroll
                for (int w8 = 0; w8 < 8; ++w8) tot += SS[w8 * 32 + r32];
                const float rstd = rsqrtf(tot * (1.f / 1024.f) + EPS);
                bf16_t* orow = A2 + (size_t)(b * SEQ + q0 + r32) * DM + hq * 128 + 4 * hh; const float* gn = p.attn_out_norm + hq * 128 + 4 * hh;
#pragma unroll
                for (int dt = 0; dt < 4; ++dt)
#pragma unroll
                    for (int g = 0; g < 4; ++g) { const f32x4 gg = *(const f32x4*)(gn + 32 * dt + 8 * g); u32x2 w;
                        w.x = pk2(ot[dt][4 * g] * rstd * gg[0], ot[dt][4 * g + 1] * rstd * gg[1]); w.y = pk2(ot[dt][4 * g + 2] * rstd * gg[2], ot[dt][4 * g + 3] * rstd * gg[3]);
                        *(u32x2*)(orow + 32 * dt + 8 * g) = w; }
            }
            lds_barrier();
        }
        { SchedPre S{G, bid, (const char*)MEMK, (const char*)MEMV, (const char*)WCQ, (const char*)WCO, (char*)WQK, (char*)WVO};
          pg8::EpiStore8 E{p.norm_cross, 0.04419417382415922f * WQK_SCALE, WVO_SCALE};
          pg8::gemm_phase<pg8::EpiStore8, SchedPre, true>(lds, DM * 2, 8, S, E, wave); }
#ifndef DBG
        xcd_barrier(xbar, wave);
#else
    }
    if (lo == 13) { PH_IDS
#endif
        {
            const int lane = lane_id_v(), tid = wave * 64 + lane, r32 = lane & 31, hh = lane >> 5;
            constexpr int XS_ = 17920;
            static_assert(8 * XS_ <= MISC_OFF, "X3 LDS");
            for (int dry = X3_DRY; dry >= 0; --dry)
            for (int it = bid; it < 256; it += G) {
                const int dir = it & 1, h = (it >> 1) & 3, b = (it >> 3) & 3, sg = it >> 5; const int vs = wave;
                if (sg == 0) continue;
                const size_t tile0 = (size_t)((b * 4 + h) * 2 + dir) * 64; bf16_t* OUT = dir ? O3 : O2;
                lds_barrier();
#pragma unroll
                for (int c8 = 0; c8 < 8; ++c8) { const int i = 8 * sg + c8; const int n = dir ? 63 - i : i; const bf16_t* q = GQ + (tile0 + n) * 8192;
#pragma unroll
                    for (int rep = 0; rep < 2; ++rep) { const int pidx = tid + 512 * rep, row = pidx >> 4, ch = pidx & 15; *(LAS bf16x8*)(lds + c8 * XS_ + row * 272 + ch * 16) = *(const bf16x8*)(q + pidx * 8); }
                    if (tid < 32) *(LAS f32x4*)(lds + c8 * XS_ + 17408 + tid * 16) = *(const f32x4*)(GD + (tile0 + n) * 128 + tid * 4); }
                f32x16 St[4];
#pragma unroll
                for (int db = 0; db < 4; ++db)
#pragma unroll
                    for (int i = 0; i < 16; ++i) St[db][i] = 0.f;
                for (int i = 0; i < sg; ++i) { const int iti = (i << 5) | (it & 31); const float* fi = FIMG + ((size_t)(iti * 8 + wave) * 64) * 64 + lane; const float* sd = SEGD + iti * 128 + 4 * hh;
                    f32x16 fv[4];
#pragma unroll
                    for (int db = 0; db < 4; ++db)
#pragma unroll
                        for (int r = 0; r < 16; ++r) fv[db][r] = fi[(db * 16 + r) * 64];
#pragma unroll
                    for (int db = 0; db < 4; ++db)
#pragma unroll
                        for (int g = 0; g < 4; ++g) { const f32x4 dv = *(const f32x4*)(sd + 32 * db + 8 * g);
#pragma unroll
                            for (int j = 0; j < 4; ++j) St[db][4 * g + j] = St[db][4 * g + j] * dv[j] + fv[db][4 * g + j]; } }
                lds_barrier();
                u32x2 oldv[2][4];
                { const int n0_ = dir ? 63 - 8 * sg : 8 * sg;
#pragma unroll
                  for (int ct = 0; ct < 2; ++ct) { const bf16_t* orow = OUT + (size_t)(b * SEQ + n0_ * 64 + 32 * ct + r32) * 1024 + h * 256 + 32 * vs + 4 * hh;
#pragma unroll
                      for (int g = 0; g < 4; ++g) oldv[ct][g] = *(const u32x2*)(orow + 8 * g); } }
                for (int c8 = 0; c8 < 8; ++c8) { const int i = 8 * sg + c8; const int n = dir ? 63 - i : i; LAS unsigned char* sb = lds + c8 * XS_;
                    f32x16 o[2];
#pragma unroll
                    for (int ct = 0; ct < 2; ++ct)
#pragma unroll
                        for (int j = 0; j < 16; ++j) o[ct][j] = 0.f;
                    u32x2 nxtv[2][4];
                    { const int nn = dir ? n - 1 : n + 1;
#pragma unroll
                      for (int ct = 0; ct < 2; ++ct) { const bf16_t* orow = OUT + (size_t)(b * SEQ + (c8 < 7 ? nn : n) * 64 + 32 * ct + r32) * 1024 + h * 256 + 32 * vs + 4 * hh;
#pragma unroll
                          for (int g = 0; g < 4; ++g) nxtv[ct][g] = *(const u32x2*)(orow + 8 * g); } }
#pragma unroll
                    for (int db = 0; db < 4; ++db)
#pragma unroll
                        for (int s = 0; s < 2; ++s) { const bf16x8 xs = pack_step(St[db], s);
#pragma unroll
                            for (int ct = 0; ct < 2; ++ct) { const LAS unsigned char* qp = sb + (32 * ct + r32) * 272 + (32 * db + 16 * s + 4 * hh) * 2;
                                const s16x4 lo4 = *(const LAS s16x4*)qp, hi4 = *(const LAS s16x4*)(qp + 16); const bf16x8 bq = __builtin_shufflevector(lo4, hi4, 0, 1, 2, 3, 4, 5, 6, 7);
                                o[ct] = MFMA32(xs, bq, o[ct]); } }
#pragma unroll
                    for (int ct = 0; ct < 2; ++ct) { bf16_t* orow = OUT + (size_t)(b * SEQ + n * 64 + 32 * ct + r32) * 1024 + h * 256 + 32 * vs + 4 * hh;
#pragma unroll
                        for (int g = 0; g < 4; ++g) { const u32x2 old = oldv[ct][g]; u32x2 w;
                            w.x = pk2(o[ct][4 * g] + bflo(old.x), o[ct][4 * g + 1] + bfhi(old.x)); w.y = pk2(o[ct][4 * g + 2] + bflo(old.y), o[ct][4 * g + 3] + bfhi(old.y)); if (!dry || w.x == 0x12345678u) *(u32x2*)(orow + 8 * g) = w; oldv[ct][g] = nxtv[ct][g]; } }
#pragma unroll
                    for (int db = 0; db < 4; ++db) {
#pragma unroll
                        for (int g = 0; g < 4; ++g) { const f32x4 dv = *(const LAS f32x4*)(sb + 17408 + (32 * db + 8 * g + 4 * hh) * 4);
#pragma unroll
                            for (int j = 0; j < 4; ++j) St[db][4 * g + j] *= dv[j]; } }
                }
            }
            lds_barrier();
        }
    }
    SEAM(3);

    if (IN(4)) for (int rp_ = 0; rp_ < (RPT == 4 ? 2 : 1); ++rp_) { PH_IDS
        {
            bf16x8 c0[6], n0[6];
            auto ld = [&](int t, bf16x8 (&d)[6]) { const size_t o = (size_t)t * 1024 + lane * 16; const size_t ro = (size_t)t * PLD + C_RG + lane * 16;
                d[0] = *(const bf16x8*)(O2 + o); d[1] = *(const bf16x8*)(O2 + o + 8);
                d[2] = *(const bf16x8*)(O3 + o); d[3] = *(const bf16x8*)(O3 + o + 8); d[4] = *(const bf16x8*)(PROJ + ro); d[5] = *(const bf16x8*)(PROJ + ro + 8); };
            const float* gn = p.gla_out_norm + (lane & 15) * 16; float gnv[16];
#pragma unroll
            for (int j = 0; j < 16; ++j) gnv[j] = gn[j];
            if (gw < NT) ld(gw, c0);
            for (int t = gw; t < NT; t += NGW) {
                const int tn = t + NGW; ld(tn < NT ? tn : t, n0);
                float v[16], a[8], r[16];
                unpack8(c0[0], v); unpack8(c0[1], v + 8);
                unpack8(c0[2], a);
#pragma unroll
                for (int j = 0; j < 8; ++j) v[j] += a[j];
                unpack8(c0[3], a);
#pragma unroll
                for (int j = 0; j < 8; ++j) v[8 + j] += a[j];
                unpack8(c0[4], r); unpack8(c0[5], r + 8);
                float ss = 0.f;
#pragma unroll
                for (int j = 0; j < 16; ++j) ss += v[j] * v[j];
                ss += __shfl_xor(ss, 1); ss += __shfl_xor(ss, 2); ss += __shfl_xor(ss, 4); ss += __shfl_xor(ss, 8);
                const float rstd = rsqrtf(ss * (1.f / 256.f) + EPS); float w[16];
#pragma unroll
                for (int j = 0; j < 16; ++j) { const float rr = r[j]; w[j] = v[j] * rstd * gnv[j] * (rr / (1.f + __expf(-rr))); }
                *(bf16x8*)(A2 + (size_t)t * DM + 1024 + lane * 16) = pack8(w); *(bf16x8*)(A2 + (size_t)t * DM + 1024 + lane * 16 + 8) = pack8(w + 8);
#pragma unroll
                for (int j = 0; j < 6; ++j) c0[j] = n0[j];
            }
        }
    }
    SEAM(4);

    if (IN(5)) for (int rp_ = 0; rp_ < (RPT == 5 ? 2 : 1); ++rp_) { PH_IDS
        SchedTok S{G, bid, 8, (const char*)A2, (const char*)WOUT, (size_t)256 * DM * 2, (size_t)256 * DM * 2, 0};
        pg8::EpiRes1 E{p.x, H1B, H1F8, SSQ};
        pg8::gemm_phase<pg8::EpiRes1, SchedTok, true>(lds, DM * 2, DM / 64, S, E, wave);
    }
    SEAM(5);

    if (IN(6)) for (int rp_ = 0; rp_ < (RPT == 6 ? 2 : 1); ++rp_) { PH_IDS
        SchedTok S{G, bid, 4, (const char*)H1F8, (const char*)WQK, (size_t)256 * DM, (size_t)256 * DM, (size_t)1024 * DM};
        pg8::EpiSoftmax E{SSQ, PB};
        for (int i = 0;; ++i) { SchedOne S1; if (!S.next(i, S1.u0)) break; pg8::gemm_phase<pg8::EpiSoftmax, SchedOne, false, true>(lds, DM, DM / 128, S1, E, wave); }
    }
    SEAM(6);

    if (IN(7)) for (int rp_ = 0; rp_ < (RPT == 7 ? 2 : 1); ++rp_) { PH_IDS
        SchedTok S{G, bid, 8, (const char*)PB, (const char*)WVO, (size_t)256 * 1024, (size_t)256 * 1024, (size_t)2048 * 1024};
#if P7_DRY
        { pg8::EpiRes2<false> E0{H1B, (bf16_t*)(ws + 707 * MiB), nullptr, nullptr}; pg8::gemm_phase<pg8::EpiRes2<false>, SchedTok, true, true>(lds, 1024, 1024 / 128, S, E0, wave); }
#endif
        pg8::EpiRes2<true> E{H1B, H1B, HN8, p.norm_ffn};
        pg8::gemm_phase<pg8::EpiRes2<true>, SchedTok, true, true>(lds, 1024, 1024 / 128, S, E, wave);
    }
    SEAM(7);

    if (IN(8)) for (int rp_ = 0; rp_ < (RPT == 8 ? 2 : 1); ++rp_) { PH_IDS
        LAS float* LG = (LAS float*)(lds + (wave & 3) * 4096);
        LAS float* PT = (LAS float*)(lds + 16384 + (wave & 3) * 4096);
        for (int tile0 = 0; tile0 < NT / 16; tile0 += 4 * G) {
            const int tile = tile0 + (wave & 3) * G + bid; const bool act = tile < NT / 16; const int kh = wave >> 2;
            const int t0 = (act ? tile : 0) * 16, i16 = lane & 15, kq = lane >> 4;
            const bf16_t* xr = H1B + (size_t)(t0 + i16) * DM + 4 * kq + 1024 * kh; f32x4 acc[3]; float ss = 0.f;
#pragma unroll
            for (int c = 0; c < 3; ++c) acc[c] = (f32x4){0.f, 0.f, 0.f, 0.f};
            if (act) {
#pragma unroll 8
            for (int kb = 0; kb < 64; ++kb) { const u32x2 ab = *(const u32x2*)(xr + 16 * kb); const f32x4 a = {bflo(ab.x), bfhi(ab.x), bflo(ab.y), bfhi(ab.y)}; ss += (a[0] * a[0] + a[1] * a[1]) + (a[2] * a[2] + a[3] * a[3]);
#pragma unroll
                for (int c = 0; c < 3; ++c) { const f32x4 bw = ((const f32x4*)WR)[((64 * kh + kb) * 3 + c) * 64 + lane];
#pragma unroll
                    for (int e = 0; e < 4; ++e) acc[c] = __builtin_amdgcn_mfma_f32_16x16x4f32(a[e], bw[e], acc[c], 0, 0, 0); } }
            }
            if (kh == 1) {
#pragma unroll
                for (int c = 0; c < 3; ++c) *(LAS f32x4*)(PT + (c * 64 + lane) * 4) = acc[c];
                PT[768 + lane] = ss; }
            __syncthreads();
            if (kh == 0) {
#pragma unroll
                for (int c = 0; c < 3; ++c) acc[c] = acc[c] + *(const LAS f32x4*)(PT + (c * 64 + lane) * 4);
                ss += PT[768 + lane];
                ss += __shfl_xor(ss, 16); ss += __shfl_xor(ss, 32);
                const float rstd = rsqrtf(ss * (1.f / DM) + EPS);
#pragma unroll
                for (int c = 0; c < 3; ++c)
#pragma unroll
                    for (int r = 0; r < 4; ++r) LG[(4 * kq + r) * 48 + 16 * c + i16] = acc[c][r];
                if (kq == 0) LG[768 + i16] = rstd;
            }
            asm volatile("s_waitcnt lgkmcnt(0)" ::: "memory");
            if (kh == 0 && act)
            if (lane < 16) { const int t = t0 + lane; const float rs = LG[768 + lane]; const LAS float* l = LG + lane * 48;
                float g[4]; int gi = 0;
#pragma unroll
                for (int j = 0; j < 4; ++j) g[j] = l[j] * rs + p.b_rg[j];
                float gm = g[0];
#pragma unroll
                for (int j = 1; j < 4; ++j) if (g[j] > gm) { gm = g[j]; gi = j; }
                float gs = 0.f;
#pragma unroll
                for (int j = 0; j < 4; ++j) gs += __expf(g[j] - gm);
                const float pg = 1.f / gs;
                float e1 = -3.0e38f, e2 = -3.0e38f; int i1 = 0, i2 = 0;
                for (int j = 0; j < 8; ++j) { const float v = l[4 + gi * 8 + j] * rs + p.b_re[gi * 8 + j]; if (v > e1) { e2 = e1; i2 = i1; e1 = v; i1 = j; } else if (v > e2) { e2 = v; i2 = j; } }
                const float w2 = __expf(e2 - e1); const float g1 = pg / (1.f + w2), g2 = pg * w2 / (1.f + w2);
                const int ea = gi * 8 + i1, eb = gi * 8 + i2;
                const int sa = (int)atomicAdd(CNT + ea, 1u), sb2 = (int)atomicAdd(CNT + eb, 1u);
                LIST[ea * 16384 + sa] = t; LIST[eb * 16384 + sb2] = t;
                ASG_E[2 * t] = ea; ASG_E[2 * t + 1] = eb; ASG_S[2 * t] = sa; ASG_S[2 * t + 1] = sb2; ASG_G[2 * t] = g1; ASG_G[2 * t + 1] = g2; RSTD3[t] = rs; }
            __syncthreads();
        }
    }
    SEAM(8);

    if (IN(9)) for (int rp_ = 0; rp_ < (RPT == 9 ? 2 : 1); ++rp_) { PH_IDS }

    if (IN(10)) for (int rp_ = 0; rp_ < (RPT == 10 ? 2 : 1); ++rp_) { PH_IDS
        moe_table(CNT, TBL, tid);
        LAS float* RSB = (LAS float*)(lds + MISC_OFF + 4608);
        SchedMoe S{TBL, LIST, RSTD3, RSB, G, bid, __builtin_amdgcn_readfirstlane(TBL[0]), TBL + 64, (const char*)HN8, (const char*)WGU, (char*)HID, (size_t)0, (size_t)2048 * DM, (size_t)256 * DM, (size_t)256 * DFF, 128, DFF, MOE1_REP};
        pg8::EpiHid E{RSB};
        pg8::gemm_phase<pg8::EpiHid, SchedMoe, true, true, true>(lds, DM, DM / 128, S, E, wave);
        __syncthreads();
    }
    SEAM(10);

    if (IN(11)) for (int rp_ = 0; rp_ < (RPT == 11 ? 2 : 1); ++rp_) { PH_IDS
        moe_table(CNT, TBL, tid);
        SchedMoe S{TBL, nullptr, nullptr, nullptr, G, bid, __builtin_amdgcn_readfirstlane(TBL[0]), TBL + 64, (const char*)HID, (const char*)WD, (char*)YS, (size_t)256 * DFF, (size_t)2048 * DFF, (size_t)256 * DFF, (size_t)256 * DM, 256, DM, MOE2_REP};
        pg8::EpiStore8 E{nullptr, 0.f, YS_SCALE / (W_SCALE * HID_SCALE)};
        pg8::gemm_phase<pg8::EpiStore8, SchedMoe, true, true>(lds, DFF, DFF / 128, S, E, wave);
        __syncthreads();
    }
    SEAM(11);

    if (IN(12)) for (int rp_ = 0; rp_ < (RPT == 12 ? 2 : 1); ++rp_) { PH_IDS
        moe_table(CNT, TBL, tid);
        const f32x4* grf = (const f32x4*)p.norm_final + lane; f32x4 gfin[8];
#pragma unroll
        for (int j = 0; j < 8; ++j) gfin[j] = grf[64 * j];
        for (int base = 0; base < NT; base += 8 * NGW) {
        int mda[8], mdb[8]; float mga[8], mgb[8];
#pragma unroll
        for (int q = 0; q < 8; ++q) { const int t = base + gw + q * NGW; const int tt = t < NT ? t : 0; mda[q] = TBL[1 + ASG_E[2 * tt]] * 256 + ASG_S[2 * tt]; mdb[q] = TBL[1 + ASG_E[2 * tt + 1]] * 256 + ASG_S[2 * tt + 1]; mga[q] = ASG_G[2 * tt]; mgb[q] = ASG_G[2 * tt + 1]; }
        for (int dry = P12_DRY; dry >= 0; --dry)
#pragma unroll
        for (int q = 0; q < 8; ++q) { const int t = base + gw + q * NGW; if (t >= NT) break;
            const int da = mda[q], db = mdb[q]; const float ga = mga[q] * (1.f / YS_SCALE), gb = mgb[q] * (1.f / YS_SCALE);
            f32x4* xr = (f32x4*)(H + (size_t)t * DM) + lane; const u32x2* hr = (const u32x2*)(H1B + (size_t)t * DM) + lane; const unsigned* ya = (const unsigned*)(YS + (size_t)da * DM) + lane; const unsigned* yb = (const unsigned*)(YS + (size_t)db * DM) + lane;
            f32x4 v[8]; float s = 0.f;
#pragma unroll
            for (int j = 0; j < 8; ++j) { const u32x2 hb = hr[64 * j]; v[j] = (f32x4){bflo(hb.x), bfhi(hb.x), bflo(hb.y), bfhi(hb.y)}; const unsigned a = ya[64 * j], b2 = yb[64 * j];
                v[j][0] += ga * __builtin_amdgcn_cvt_f32_fp8((int)a, 0) + gb * __builtin_amdgcn_cvt_f32_fp8((int)b2, 0); v[j][1] += ga * __builtin_amdgcn_cvt_f32_fp8((int)a, 1) + gb * __builtin_amdgcn_cvt_f32_fp8((int)b2, 1);
                v[j][2] += ga * __builtin_amdgcn_cvt_f32_fp8((int)a, 2) + gb * __builtin_amdgcn_cvt_f32_fp8((int)b2, 2); v[j][3] += ga * __builtin_amdgcn_cvt_f32_fp8((int)a, 3) + gb * __builtin_amdgcn_cvt_f32_fp8((int)b2, 3);
                s += (v[j][0] * v[j][0] + v[j][1] * v[j][1]) + (v[j][2] * v[j][2] + v[j][3] * v[j][3]); }
            const float rstd = rsqrtf(wave_sum(s) * (1.f / DM) + EPS);
#pragma unroll
            for (int j = 0; j < 8; ++j) { const f32x4 g = gfin[j]; f32x4 o; o[0] = v[j][0] * rstd * g[0]; o[1] = v[j][1] * rstd * g[1]; o[2] = v[j][2] * rstd * g[2]; o[3] = v[j][3] * rstd * g[3]; (dry ? ((f32x4*)(ws + 555 * MiB) + (size_t)t * 512 + lane) : xr)[64 * j] = o; }
        }
        }
    }
    for (int xb_ = 0; xb_ < XBAR_EXTRA; ++xb_) xcd_barrier(xbar, wave);
#undef IN
#undef SEAM
}


#undef WGU
#undef WD
#undef WIN
#undef WCKV
#undef WOUT
#undef WCO
#undef WCQ
#undef WQK
#undef WVO
#undef U
#undef H1B
#undef H1F8
#undef HN8
#undef LIST
#undef MEMN
#undef MEMK
#undef MEMV
#undef PROJ
#undef PB
#undef GQ
#undef GK
#undef GD
#undef O1
#undef O2
#undef O3
#undef A2
#undef SSQ
#undef XS
#undef HID
#undef YS
#undef WR
#undef FIMG
#undef SEGD
#undef ASG_E
#undef ASG_S
#undef ASG_G
#undef RSTD3
#undef DEST
#undef CNT
#ifdef DBG
__device__ __forceinline__ unsigned hsh(unsigned x) { x ^= x >> 16; x *= 0x7feb352dU; x ^= x >> 15; x *= 0x846ca68bU; x ^= x >> 16; return x; }
__device__ __forceinline__ float bfr(float f) { unsigned w = pk2(f, 0.f); return bflo(w); }
__device__ __forceinline__ void rec(unsigned* errs, int slot, float got, float want, float atol) {
    float e = fabsf(got - want) / (fabsf(want) + atol); if (!(e == e)) e = 1.0e9f; if (!(got == got)) e = 1.0e9f;
    atomicMax(errs + slot, __float_as_uint(e));
}
__device__ __forceinline__ void rec8(unsigned* errs, int slot, float got, float want, float atol) { rec(errs, slot, want + 0.4f * (got - want), want, atol); }
__device__ __forceinline__ float wdot8(const unsigned char* a, const unsigned char* b, int K, int lane) { float s = 0.f; for (int k = lane; k < K; k += 64) s += fp8f(a[k]) * fp8f(b[k]); return wave_sum(s); }
__device__ __forceinline__ float wdot(const bf16_t* a, const bf16_t* b, int K, int lane) { float s = 0.f; for (int k = lane; k < K; k += 64) s += bf2f(a[k]) * bf2f(b[k]); return wave_sum(s); }
__device__ __forceinline__ float lsig16(float pre) { return (fminf(pre, 0.f) - logf(1.f + expf(-fabsf(pre)))) * (1.f / 16.f); }
__device__ __forceinline__ float gate_at(const Params& p, const bf16_t* PROJ, int row, int h, int d, int dir) {
    const float* wg = dir ? p.w_gla_gb : p.w_gla_gf; float pre = (dir ? p.b_gla_gb : p.b_gla_gf)[h * 128 + d];
    for (int r = 0; r < 16; ++r) pre += bf2f(PROJ[(size_t)row * PLD + C_LRF + 16 * dir + r]) * wg[r * 512 + h * 128 + d];
    return lsig16(pre);
}
__global__ void __launch_bounds__(256) chk_kernel(Params p, int stage, unsigned* errs) {
    __shared__ float sh[4][1536];
    const int lane = threadIdx.x & 63, wv = threadIdx.x >> 6, gwv = blockIdx.x * 4 + wv, NW = gridDim.x * 4;
    unsigned char* ws = p.ws;
    unsigned char* WGU = (unsigned char*)(ws + WS_WGU); unsigned char* WD = (unsigned char*)(ws + WS_WD); bf16_t* WIN = (bf16_t*)(ws + WS_WIN); bf16_t* WCKV = (bf16_t*)(ws + WS_WCKV);
    bf16_t* WOUT = (bf16_t*)(ws + WS_WOUT); bf16_t* WCO = (bf16_t*)(ws + WS_WCO); bf16_t* WCQ = (bf16_t*)(ws + WS_WCQ);
    unsigned char* WQK = (unsigned char*)(ws + WS_WQK); unsigned char* WVO = (unsigned char*)(ws + WS_WVO); unsigned char* H1F8 = (unsigned char*)(ws + WS_H1F8);
    bf16_t* U = (bf16_t*)(ws + WS_U); bf16_t* H1B = (bf16_t*)(ws + WS_H1B); bf16_t* MEMN = (bf16_t*)(ws + WS_MEMN); bf16_t* MEMK = (bf16_t*)(ws + WS_MEMK); bf16_t* MEMV = (bf16_t*)(ws + WS_MEMV);
    bf16_t* PROJ = (bf16_t*)(ws + WS_PROJ); unsigned char* PB = (unsigned char*)(ws + WS_P); bf16_t* GQ = (bf16_t*)(ws + WS_GQ); bf16_t* GK = (bf16_t*)(ws + WS_GK); float* GD = (float*)(ws + WS_GD);
    bf16_t* O1 = (bf16_t*)(ws + WS_O1); bf16_t* O2 = (bf16_t*)(ws + WS_O2); bf16_t* O3 = (bf16_t*)(ws + WS_O3); bf16_t* A2 = (bf16_t*)(ws + WS_A2);
    float* SSQ = (float*)(ws + WS_SSQ); unsigned char* XS = (unsigned char*)(ws + WS_XS); unsigned char* HID = (unsigned char*)(ws + WS_HID); unsigned char* YS = (unsigned char*)(ws + WS_YS);
    float* WR = (float*)(ws + WS_WR);
    int* ASG_E = (int*)(ws + WS_ASG); int* ASG_S = ASG_E + 2 * NT; float* ASG_G = (float*)(ASG_S + 2 * NT); float* RSTD3 = ASG_G + 2 * NT; int* DEST = (int*)(RSTD3 + NT);
    unsigned* CNT = (unsigned*)(ws + WS_CTL) + CW_CNT;
    float* H = p.out; float* shw = sh[wv];
    const int NS = 16;
    for (int si = 0; si < NS; ++si) {
        const unsigned r0 = hsh((unsigned)(gwv * NS + si) * 2654435761u + (unsigned)stage * 97u + 12345u), r1 = hsh(r0 + 1u), r2 = hsh(r0 + 2u), r3 = hsh(r0 + 3u);
        if (stage == 0) {
            const unsigned q0 = hsh(r0 + lane * 7919u), q1 = hsh(q0 + 1u), q2 = hsh(q0 + 2u);
            { const int n = q0 % 4864, k = q1 % 2048; const float want = n < 4640 ? bfr(p.w_in[(size_t)k * 4640 + n]) : 0.f; rec(errs, 0 * 4 + 0, bf2f(WIN[(size_t)n * DM + k]), want, 1e-4f); }
            { const int n = q0 % 2048, k = q1 % 2048;
              rec(errs, 0 * 4 + 0, bf2f(WCKV[(size_t)n * DM + k]), bfr(p.w_ck[(size_t)k * DM + n]), 1e-4f); rec(errs, 0 * 4 + 0, bf2f(WCKV[(size_t)(2048 + n) * DM + k]), bfr(p.w_cv[(size_t)k * DM + n]), 1e-4f); }
            { const int t = r1 % NT; float s = 0.f; for (int k = lane; k < DM; k += 64) { const float v = p.x[(size_t)t * DM + k]; s += v * v; } const float rs = rsqrtf(wave_sum(s) / DM + EPS);
              const int k = q0 % DM; rec(errs, 0 * 4 + 0, bf2f(U[(size_t)t * DM + k]), p.x[(size_t)t * DM + k] * rs * p.norm_mix[k], 1e-2f); }
            { const int t = r1 % 1024; float s = 0.f; for (int k = lane; k < DM; k += 64) { const float v = p.mem[(size_t)t * DM + k]; s += v * v; } const float rs = rsqrtf(wave_sum(s) / DM + EPS);
              const int k = q0 % DM; rec(errs, 0 * 4 + 0, bf2f(MEMN[(size_t)t * DM + k]), p.mem[(size_t)t * DM + k] * rs * p.norm_mem[k], 1e-2f); }
        } else if (stage == 1) {
            { const unsigned q0 = hsh(r0 + lane * 7919u), q1 = hsh(q0 + 1u), q2 = hsh(q0 + 2u);
              { const int n = q0 % 2048, k = q1 % 2048; rec(errs, 1 * 4 + 3, bf2f(WOUT[(size_t)n * DM + k]), bfr(p.w_out[(size_t)k * DM + n]), 1e-4f);
                rec(errs, 1 * 4 + 3, bf2f(WCO[(size_t)n * DM + k]), bfr(p.w_co[(size_t)k * DM + n]), 1e-4f); rec(errs, 1 * 4 + 3, bf2f(WCQ[(size_t)n * DM + k]), bfr(p.w_cq[(size_t)n * DM + k]), 1e-4f); }
            { const int e = q2 % 32, k = q1 % 2048, j = q0 % 1024; rec8(errs, 1 * 4 + 2, fp8f(WGU[((size_t)e * 2048 + (j >> 7) * 256 + (j & 127)) * DM + k]), W_SCALE * p.w_gate[((size_t)e * DM + k) * DFF + j], 2e-2f);
              rec8(errs, 1 * 4 + 2, fp8f(WGU[((size_t)e * 2048 + (j >> 7) * 256 + 128 + (j & 127)) * DM + k]), W_SCALE * p.w_up[((size_t)e * DM + k) * DFF + j], 2e-2f);
              const int n = q0 % 2048, kk = q1 % 1024; rec8(errs, 1 * 4 + 2, fp8f(WD[((size_t)e * 2048 + n) * DFF + kk]), W_SCALE * p.w_down[((size_t)e * DFF + kk) * DM + n], 2e-2f); }
            }
            { const int t = r0 % NT, n = r1 % 4864; const float want = wdot(U + (size_t)t * DM, WIN + (size_t)n * DM, DM, lane); if (lane == 0) rec(errs, 1 * 4 + 0, bf2f(PROJ[(size_t)t * PLD + n]), want, 1.0f); }
            { const int t = r2 % 1024, n = r3 % 4096; const float want = wdot(MEMN + (size_t)t * DM, WCKV + (size_t)n * DM, DM, lane);
              if (lane == 0) rec(errs, 1 * 4 + 1, bf2f((n < 2048 ? MEMK : MEMV)[(size_t)t * DM + (n & 2047)]), want, 1.0f); }
        } else if (stage == 2) {
        } else if (stage == 3) {
            if (si < 2) {
                const int b = r0 & 3, h = (r0 >> 2) & 3, dir = (r0 >> 4) & 1, tpos = r1 % SEQ, v = r2 & 255; const int row = b * SEQ + tpos;
                float E0 = 0.f, E1 = 0.f, acc = 0.f; const float q0 = bf2f(PROJ[(size_t)row * PLD + C_QG + h * 128 + lane]) * 0.08838834764831845f, q1 = bf2f(PROJ[(size_t)row * PLD + C_QG + h * 128 + lane + 64]) * 0.08838834764831845f;
                for (int st_ = 0; st_ < 768; ++st_) { const int s = dir ? tpos + st_ : tpos - st_; if (s < 0 || s >= SEQ) break; const int srow = b * SEQ + s;
                    float a = q0 * expf(E0) * bf2f(PROJ[(size_t)srow * PLD + C_KG + h * 128 + lane]) + q1 * expf(E1) * bf2f(PROJ[(size_t)srow * PLD + C_KG + h * 128 + lane + 64]);
                    a = wave_sum(a); acc += a * bf2f(PROJ[(size_t)srow * PLD + C_VG + h * 256 + v]);
                    if (dir == 0) { E0 += gate_at(p, PROJ, srow, h, lane, 0); E1 += gate_at(p, PROJ, srow, h, lane + 64, 0); }
                    else { E0 += gate_at(p, PROJ, srow, h, lane, 1); E1 += gate_at(p, PROJ, srow, h, lane + 64, 1); } }
                if (lane == 0) rec(errs, 3 * 4 + 0, bf2f((dir ? O3 : O2)[(size_t)row * 1024 + h * 256 + v]), acc, 2.0f);
            } else if (si < 8) {
                const int b = r0 & 3, tpos = r1 % SEQ; const int row = b * SEQ + tpos; float* pr = shw; float* oh = shw + 320; float tot = 0.f;
                for (int hq = 0; hq < 8; ++hq) { const int kvh = hq >> 2; const float slope = exp2f(-(float)(hq + 1)); float mx = p.sink_logit[hq];
                    for (int j = lane; j < 257; j += 64) { const int kp = tpos - 128 + j; float sc = -3.0e38f;
                        if (kp >= 0 && kp < SEQ) { float s = 0.f; for (int d = 0; d < 128; ++d) s += bf2f(PROJ[(size_t)row * PLD + C_QA + hq * 128 + d]) * bf2f(PROJ[(size_t)(b * SEQ + kp) * PLD + C_KA + kvh * 128 + d]);
                            sc = s * 0.08838834764831845f - slope * fabsf((float)(kp - tpos)); }
                        pr[j] = sc; mx = fmaxf(mx, sc); }
                    for (int o = 1; o < 64; o <<= 1) mx = fmaxf(mx, __shfl_xor(mx, o));
                    float sm = 0.f; for (int j = lane; j < 257; j += 64) { const float e = pr[j] > -1.0e38f ? expf(pr[j] - mx) : 0.f; pr[j] = e; sm += e; }
                    sm = wave_sum(sm) + expf(p.sink_logit[hq] - mx);
                    __builtin_amdgcn_s_waitcnt(0);
                    for (int dd = 0; dd < 2; ++dd) { const int d = lane + 64 * dd; float o = 0.f;
                        for (int j = 0; j < 257; ++j) { const int kp = tpos - 128 + j; if (kp >= 0 && kp < SEQ) o += pr[j] * bf2f(PROJ[(size_t)(b * SEQ + kp) * PLD + C_VA + kvh * 128 + d]); }
                        o /= sm; oh[hq * 128 + d] = o; tot += o * o; }
                    __builtin_amdgcn_s_waitcnt(0); }
                tot = wave_sum(tot); const float rs = rsqrtf(tot / 1024.f + EPS);
                for (int i = lane; i < 1024; i += 64) rec(errs, 3 * 4 + 1, bf2f(A2[(size_t)row * DM + i]), oh[i] * rs * p.attn_out_norm[i], 1.0f);
            } else {
                const int b = r0 & 3, h = (r0 >> 2) & 3, m = r1 & 255, c = r2 & 2047;
                float s = 0.f; for (int d = lane; d < 512; d += 64) s += bf2f(MEMK[(size_t)(b * 256 + m) * DM + h * 512 + d]) * bf2f(WCQ[(size_t)c * DM + h * 512 + d]); s = wave_sum(s) * p.norm_cross[c] * 0.04419417382415922f;
                if (lane == 0) rec8(errs, 3 * 4 + 2, fp8f(WQK[((size_t)b * 1024 + h * 256 + m) * DM + c]) / WQK_SCALE, s, 0.02f);
                s = 0.f; for (int d = lane; d < 512; d += 64) s += bf2f(MEMV[(size_t)(b * 256 + m) * DM + h * 512 + d]) * bf2f(WCO[(size_t)c * DM + h * 512 + d]); s = wave_sum(s);
                if (lane == 0) rec8(errs, 3 * 4 + 3, fp8f(WVO[((size_t)b * 2048 + c) * 1024 + h * 256 + m]) / WVO_SCALE, s, 0.5f);
            }
        } else if (stage == 4) {
            const int t = r0 % NT;
            for (int hh = 0; hh < 4; ++hh) { float vv[4]; float ss = 0.f;
_Pragma("unroll")
                for (int j = 0; j < 4; ++j) { const size_t o = (size_t)t * 1024 + hh * 256 + lane + 64 * j; vv[j] = bf2f(O2[o]) + bf2f(O3[o]); ss += vv[j] * vv[j]; }
                ss = wave_sum(ss); const float rs = rsqrtf(ss / 256.f + EPS);
_Pragma("unroll")
                for (int j = 0; j < 4; ++j) { const int v = lane + 64 * j; const float r = bf2f(PROJ[(size_t)t * PLD + C_RG + hh * 256 + v]);
                    rec(errs, 4 * 4 + 0, bf2f(A2[(size_t)t * DM + 1024 + hh * 256 + v]), vv[j] * rs * p.gla_out_norm[v] * (r / (1.f + expf(-r))), 0.5f); } }
        } else if (stage == 5) {
            const int t = r0 % NT, n = r1 % DM; const float want = p.x[(size_t)t * DM + n] + wdot(A2 + (size_t)t * DM, WOUT + (size_t)n * DM, DM, lane);
            if (lane == 0) { rec(errs, 5 * 4 + 1, bf2f(H1B[(size_t)t * DM + n]), want, 1.0f); }
            float s = 0.f; for (int k = lane; k < DM; k += 64) { const float v = bf2f(H1B[(size_t)t * DM + k]); s += v * v; } s = wave_sum(s);
            float q = lane < 32 ? SSQ[(size_t)t * 32 + lane] : 0.f; q = wave_sum(q); if (lane == 0) rec(errs, 5 * 4 + 2, q, s, 1.0f);
        } else if (stage == 6) {
            const int t = r0 % NT, h = r1 & 3, b = t / SEQ; float s = 0.f; for (int k = lane; k < DM; k += 64) { const float v = bf2f(H1B[(size_t)t * DM + k]); s += v * v; } const float rs = rsqrtf(wave_sum(s) / DM + EPS);
            float sc[4]; float mx = -3.0e38f;
_Pragma("unroll")
            for (int j = 0; j < 4; ++j) { const int m = lane + 64 * j; float a = 0.f; for (int k = 0; k < DM; ++k) a += fp8f(H1F8[(size_t)t * DM + k]) * fp8f(WQK[((size_t)b * 1024 + h * 256 + m) * DM + k]); sc[j] = a * rs / WQK_SCALE; mx = fmaxf(mx, sc[j]); }
            for (int o = 1; o < 64; o <<= 1) mx = fmaxf(mx, __shfl_xor(mx, o));
            float sm = 0.f;
_Pragma("unroll")
            for (int j = 0; j < 4; ++j) { sc[j] = expf(sc[j] - mx); sm += sc[j]; } sm = wave_sum(sm);
_Pragma("unroll")
            for (int j = 0; j < 4; ++j) rec8(errs, 6 * 4 + 0, fp8f(PB[(size_t)t * 1024 + h * 256 + lane + 64 * j]) / P_SCALE, sc[j] / sm, 4e-3f);
        } else if (stage == 7) {
            const int t = r0 % NT, n = r1 % DM, b = t / SEQ; const float want = bf2f(H1B[(size_t)t * DM + n]) + 0.f * wdot8(PB + (size_t)t * 1024, WVO + ((size_t)b * 2048 + n) * 1024, 1024, lane);
            if (lane == 0) rec(errs, 7 * 4 + 0, bf2f(H1B[(size_t)t * DM + n]), want, 0.3f);
        } else if (stage == 8) {
            const int t = r0 % NT; double s = 0.0; for (int k = lane; k < DM; k += 64) { const double v = bf2f(H1B[(size_t)t * DM + k]); s += v * v; }
            for (int o = 1; o < 64; o <<= 1) s += __shfl_xor(s, o);
            const double rs = 1.0 / sqrt(s / DM + 1e-6); float* lg = shw;
            for (int j = 0; j < 36; ++j) { double a = 0.0; for (int k = lane; k < DM; k += 64) { const double w = j < 4 ? p.w_rg[k * 4 + j] : p.w_re[k * 32 + j - 4]; a += (double)bf2f(H1B[(size_t)t * DM + k]) * rs * p.norm_ffn[k] * w; }
                for (int o = 1; o < 64; o <<= 1) a += __shfl_xor(a, o); if (lane == 0) lg[j] = (float)(a + (j < 4 ? p.b_rg[j] : p.b_re[j - 4])); }
            __builtin_amdgcn_s_waitcnt(0);
            if (lane == 0) { int gi = 0; for (int j = 1; j < 4; ++j) if (lg[j] > lg[gi]) gi = j; float gs = 0; for (int j = 0; j < 4; ++j) gs += expf(lg[j] - lg[gi]); const float pg = 1.f / gs;
                int i1 = 0; for (int j = 1; j < 8; ++j) if (lg[4 + gi * 8 + j] > lg[4 + gi * 8 + i1]) i1 = j; int i2 = -1; for (int j = 0; j < 8; ++j) if (j != i1 && (i2 < 0 || lg[4 + gi * 8 + j] > lg[4 + gi * 8 + i2])) i2 = j;
                const float w2 = expf(lg[4 + gi * 8 + i2] - lg[4 + gi * 8 + i1]);
                rec(errs, 8 * 4 + 0, (float)(ASG_E[2 * t] != gi * 8 + i1), 0.f, 1e-6f); rec(errs, 8 * 4 + 0, (float)(ASG_E[2 * t + 1] != gi * 8 + i2), 0.f, 1e-6f);
                rec(errs, 8 * 4 + 1, ASG_G[2 * t], pg / (1 + w2), 1e-3f); rec(errs, 8 * 4 + 1, ASG_G[2 * t + 1], pg * w2 / (1 + w2), 1e-3f); rec(errs, 8 * 4 + 2, RSTD3[t], (float)rs, 1e-6f);
                const int sa = ASG_S[2 * t], sb = ASG_S[2 * t + 1]; if (sa < 0 || sa >= (int)CNT[ASG_E[2 * t]] || sb < 0 || sb >= (int)CNT[ASG_E[2 * t + 1]]) rec(errs, 8 * 4 + 3, 1.f, 0.f, 1e-6f); }
            __builtin_amdgcn_s_waitcnt(0);
        } else if (stage == 9 || stage == 10 || stage == 11) {
            const int t = r0 % NT, kk = r1 & 1; const int e = ASG_E[2 * t + kk]; int pst = 0; for (int j = 0; j < e; ++j) pst += ((int)CNT[j] + 255) >> 8; const int dst = pst * 256 + ASG_S[2 * t + kk];
            if (stage == 9) { }
            else if (stage == 10) { const int j = r2 % 1024; const unsigned char* HN8c = (const unsigned char*)(ws + WS_H1F8); const float g = wdot8(HN8c + (size_t)t * DM, WGU + ((size_t)e * 2048 + (j >> 7) * 256 + (j & 127)) * DM, DM, lane) * RSTD3[t] / W_SCALE, u = wdot8(HN8c + (size_t)t * DM, WGU + ((size_t)e * 2048 + (j >> 7) * 256 + 128 + (j & 127)) * DM, DM, lane) * RSTD3[t] / W_SCALE;
                if (lane == 0) rec8(errs, 10 * 4 + 0, fp8f(HID[(size_t)dst * DFF + j]) / HID_SCALE, g / (1.f + expf(-g)) * u, 0.5f); }
            else { const int n = r2 % DM; const float y = wdot8(HID + (size_t)dst * DFF, WD + ((size_t)e * 2048 + n) * DFF, DFF, lane) / (W_SCALE * HID_SCALE); if (lane == 0) rec8(errs, 11 * 4 + 0, fp8f(YS[(size_t)dst * DM + n]) / YS_SCALE, y, 0.6f); }
        }
    }
}
__global__ void apply_kernel(float* out, const unsigned* errs, int n) {
    int code = 0;
    for (int s = 51; s >= 0; --s) if (__uint_as_float(errs[s]) > DBG_THR) code = s + 1;
    if (code == 0) return;
    for (int i = blockIdx.x * blockDim.x + threadIdx.x; i < n; i += gridDim.x * blockDim.x) out[i] *= (float)(1 + code);
}
#endif
extern "C" void kernel_launch(void* const* d_in, const int* in_sizes, int n_in, void* d_out, int out_size, void* d_ws, size_t ws_size, hipStream_t stream) {
    static int grid = 0;
    if (grid == 0) {
        if (n_in != 27 || out_size != NT * DM || ws_size < WS_END) { fprintf(stderr, "kernel_launch: unexpected problem: n_in %d out %d ws %zu (need %zu)\n", n_in, out_size, ws_size, (size_t)WS_END); grid = -1; return; }
        int dev = 0, cus = 0, per_cu = 0;
        if (hipGetDevice(&dev) != hipSuccess || hipDeviceGetAttribute(&cus, hipDeviceAttributeMultiprocessorCount, dev) != hipSuccess) { grid = -1; return; }
        if (hipFuncSetAttribute((const void*)fwd_mega, hipFuncAttributeMaxDynamicSharedMemorySize, LDS_BYTES) != hipSuccess) { fprintf(stderr, "kernel_launch: hipFuncSetAttribute failed\n"); grid = -1; return; }
        if (hipOccupancyMaxActiveBlocksPerMultiprocessor(&per_cu, (const void*)fwd_mega, 512, LDS_BYTES) != hipSuccess || per_cu < 1) { fprintf(stderr, "kernel_launch: occupancy query says %d blocks per CU\n", per_cu); grid = -1; (void)hipGetLastError(); return; }
        grid = cus;
    }
    if (grid < 0) return;
    (void)hipMemsetAsync((char*)d_ws + WS_CTL, 0, 32768, stream);
    Params p{};
    const float** pf = (const float**)&p;
    for (int i = 0; i < 27; ++i) pf[i] = (const float*)d_in[i];
    p.out = (float*)d_out; p.ws = (unsigned char*)d_ws; p.ph_lo = 0; p.ph_hi = 13;

#ifdef DBG
    unsigned* errs = (unsigned*)((char*)d_ws + WS_CTL) + 1024;
    for (int ph = 0; ph < 13; ++ph) {
        p.ph_lo = ph; p.ph_hi = ph + 1;
        void* a2[] = {&p};
        (void)a2; hipLaunchKernelGGL(fwd_mega, dim3(grid), dim3(512), LDS_BYTES, stream, p);
        if (ph == 3) { p.ph_lo = 13; p.ph_hi = 14; hipLaunchKernelGGL(fwd_mega, dim3(grid), dim3(512), LDS_BYTES, stream, p); }
        if (ph < 12) hipLaunchKernelGGL(chk_kernel, dim3(64), dim3(256), 0, stream, p, ph, errs);
    }
    hipLaunchKernelGGL(apply_kernel, dim3(1024), dim3(256), 0, stream, (float*)d_out, errs, NT * DM);
    return;
#endif
    void* args[] = {&p};
    (void)args;
    hipLaunchKernelGGL(fwd_mega, dim3(grid), dim3(512), LDS_BYTES, stream, p);
    hipError_t e = hipPeekAtLastError();
    if (e != hipSuccess) fprintf(stderr, "kernel_launch: launch failed: %s (grid %d)\n", hipGetErrorString(e), grid);
}
```
